# Optimizing an MI355X kernel written in HIP

```python
import jax, jax.numpy as jnp
from jax import lax
import numpy as np

D_MODEL = 1024
BATCH = 32
SEQ = 2048
DEPTH = 1
DEC_BATCH = 1
DEC_SEQ = 16384
PAST_LEN = 128

D_MIX = D_MODEL
GLA_HEADS = 4
GLA_DV = (D_MIX // 2) // GLA_HEADS
GLA_DK = GLA_DV // 2
GLA_RANK = 16
GLA_TAU = 16.0
GLA_CHUNK = 64
ATT_HEADS = 8
ATT_DH = (D_MIX // 2) // ATT_HEADS
DILATED = ((128, 1), (512, 4), (2048, 16))
D_FF = 2816
EPS = 1e-6
NEG = -1e30

GLA_QK_W = GLA_HEADS * GLA_DK
GLA_V_W = GLA_HEADS * GLA_DV
ATT_W = ATT_HEADS * ATT_DH
D_IN = 2 * GLA_QK_W + 2 * GLA_V_W + 2 * GLA_RANK + 3 * ATT_W

kernel_name = "hymba_gla_dilated_macaron_encoder"


def rmsnorm(x, g):
    xf = x.astype(jnp.float32)
    y = xf * lax.rsqrt(jnp.mean(xf * xf, axis=-1, keepdims=True) + EPS)
    return (y * g.astype(jnp.float32)).astype(x.dtype)


def swiglu(x, wg, wu, wd):
    return (jax.nn.silu(x @ wg) * (x @ wu)) @ wd


def gla_scan(q, k, v, log_a):
    B, L, H, DK = q.shape
    DV = v.shape[-1]
    C = GLA_CHUNK
    n = L // C
    q = q.reshape(B, n, C, H, DK)
    k = k.reshape(B, n, C, H, DK)
    v = v.reshape(B, n, C, H, DV)
    b = jnp.cumsum(log_a.reshape(B, n, C, H, DK), axis=2)
    q_dec = q * jnp.exp(b)
    k_inv = k * jnp.exp(-b)
    tril = jnp.tril(jnp.ones((C, C), dtype=bool))
    A = jnp.einsum('bnthk,bnshk->bnhts', q_dec, k_inv)
    A = jnp.where(tril, A, 0.0)
    o = jnp.einsum('bnhts,bnshv->bnthv', A, v)
    b_end = b[:, :, -1]
    kv = jnp.einsum('bnshk,bnshv->bnhkv', k * jnp.exp(b_end[:, :, None] - b), v)

    def step(S, inp):
        dec, kv_c = inp
        return dec[..., None] * S + kv_c, S

    S0 = jnp.zeros((B, H, DK, DV), jnp.float32)
    _, S_prev = lax.scan(step, S0, (jnp.moveaxis(jnp.exp(b_end), 1, 0), jnp.moveaxis(kv, 1, 0)))
    o = o + jnp.einsum('bnthk,nbhkv->bnthv', q_dec, S_prev)
    return o.reshape(B, L, H, DV)


def gla_mixer(q, k, v, r, lr_f, lr_b, w_a2_f, b_a_f, w_a2_b, b_a_b, g_out):
    B, L, _ = q.shape
    f32 = jnp.float32
    qf = q.reshape(B, L, GLA_HEADS, GLA_DK).astype(f32) * (GLA_DK ** -0.5)
    kf = k.reshape(B, L, GLA_HEADS, GLA_DK).astype(f32)
    vf = v.reshape(B, L, GLA_HEADS, GLA_DV).astype(f32)
    la_f = (jax.nn.log_sigmoid((lr_f @ w_a2_f + b_a_f).astype(f32)) / GLA_TAU).reshape(B, L, GLA_HEADS, GLA_DK)
    la_b = (jax.nn.log_sigmoid((lr_b @ w_a2_b + b_a_b).astype(f32)) / GLA_TAU).reshape(B, L, GLA_HEADS, GLA_DK)
    o_f = gla_scan(qf, kf, vf, la_f)
    flip = lambda t: jnp.flip(t, axis=1)
    o_b = flip(gla_scan(flip(qf), flip(kf), flip(vf), flip(la_b)))
    o = o_f + o_b
    o = o * lax.rsqrt(jnp.mean(o * o, axis=-1, keepdims=True) + EPS)
    o = o.reshape(B, L, GLA_V_W) * g_out.astype(f32)
    return (o * jax.nn.silu(r.astype(f32))).astype(q.dtype)


def alibi_slopes(h):
    return jnp.exp2(-8.0 * jnp.arange(1, h + 1, dtype=jnp.float32) / h)


def dilated_branch(q, k, v, window, dil, slopes):
    B, L, H, D = q.shape
    R = (window // 2) // dil
    n = L // dil
    nb = -(-n // R)
    npad = nb * R
    Bd = B * dil

    def to_sub(x):
        return x.reshape(B, n, dil, H, D).transpose(0, 2, 1, 3, 4).reshape(Bd, n, H, D)

    pad_q = ((0, 0), (0, npad - n), (0, 0), (0, 0))
    pad_k = ((0, 0), (R, npad - n + R), (0, 0), (0, 0))
    qb = jnp.pad(to_sub(q), pad_q).reshape(Bd, nb, R, H, D)

    def windows(x):
        xb = jnp.pad(to_sub(x), pad_k).reshape(Bd, nb + 2, R, H, D)
        return jnp.concatenate([xb[:, :-2], xb[:, 1:-1], xb[:, 2:]], axis=2)

    kw = windows(k)
    vw = windows(v).astype(jnp.float32)
    s = jnp.einsum('bjqhd,bjkhd->bjhqk', qb, kw).astype(jnp.float32) * (D ** -0.5)
    a = jnp.arange(R)
    kk = jnp.arange(3 * R)
    rel = kk[None, :] - R - a[:, None]
    key_idx = jnp.arange(nb)[:, None] * R + kk[None, :] - R
    valid = (jnp.abs(rel) <= R)[None] & ((key_idx >= 0) & (key_idx < n))[:, None, :]
    bias = -(slopes * dil)[:, None, None] * jnp.abs(rel).astype(jnp.float32)[None]
    s = jnp.where(valid[:, None], s + bias, NEG)
    m = jnp.max(s, axis=-1, keepdims=True)
    p = jnp.exp(s - m)
    den = jnp.sum(p, axis=-1)
    o = jnp.einsum('bjhqk,bjkhd->bjqhd', p, vw) / jnp.swapaxes(den, 2, 3)[..., None]
    lse = jnp.swapaxes(m[..., 0] + jnp.log(den), 2, 3)
    o = o.reshape(Bd, npad, H, D)[:, :n]
    lse = lse.reshape(Bd, npad, H)[:, :n]
    o = o.reshape(B, dil, n, H, D).transpose(0, 2, 1, 3, 4).reshape(B, L, H, D)
    lse = lse.reshape(B, dil, n, H).transpose(0, 2, 1, 3).reshape(B, L, H)
    return o, lse


def dilated_attention(q, k, v):
    B, L, _ = q.shape
    q = q.reshape(B, L, ATT_HEADS, ATT_DH)
    k = k.reshape(B, L, ATT_HEADS, ATT_DH)
    v = v.reshape(B, L, ATT_HEADS, ATT_DH)
    slopes = alibi_slopes(ATT_HEADS)
    outs, lses = [], []
    for window, dil in DILATED:
        o_i, l_i = dilated_branch(q, k, v, window, dil, slopes)
        outs.append(o_i)
        lses.append(l_i)
    alpha = jax.nn.softmax(jnp.stack(lses, axis=0), axis=0)
    o = jnp.sum(alpha[..., None] * jnp.stack(outs, axis=0), axis=0)
    return o.reshape(B, L, ATT_W).astype(q.dtype)


def layer(x, g_ffn1, w1_gate, w1_up, w1_down, g_mix, w_in, w_a2_fwd, b_a_fwd, w_a2_bwd, b_a_bwd,
          g_gla_out, w_out, g_ffn2, w2_gate, w2_up, w2_down):
    h = x + 0.5 * swiglu(rmsnorm(x, g_ffn1), w1_gate, w1_up, w1_down)
    z = rmsnorm(h, g_mix) @ w_in
    c = np.cumsum([0, GLA_QK_W, GLA_QK_W, GLA_V_W, GLA_V_W, GLA_RANK, GLA_RANK, ATT_W, ATT_W, ATT_W])
    gq, gk, gv, gr, lr_f, lr_b, aq, ak, av = [z[..., int(c[i]):int(c[i + 1])] for i in range(9)]
    o_gla = gla_mixer(gq, gk, gv, gr, lr_f, lr_b, w_a2_fwd, b_a_fwd, w_a2_bwd, b_a_bwd, g_gla_out)
    o_att = dilated_attention(aq, ak, av)
    h = h + jnp.concatenate([o_gla, o_att], axis=-1) @ w_out
    h = h + 0.5 * swiglu(rmsnorm(h, g_ffn2), w2_gate, w2_up, w2_down)
    return h


def setup_inputs(seed: int = 0) -> dict:
    key = jax.random.key(seed)
    ks = jax.random.split(key, 20)
    f32 = jnp.float32
    nrm = lambda k, shape, fan: jax.random.normal(k, shape, f32) * (fan ** -0.5)
    gain = lambda k, shape: 1.0 + 0.02 * jax.random.normal(k, shape, f32)
    return {
        "x_prompt": jax.random.normal(ks[0], (BATCH, SEQ, D_MODEL), f32),
        "x_sample": jax.random.normal(ks[1], (DEC_BATCH, DEC_SEQ, D_MODEL), f32),
        "g_ffn1": gain(ks[2], (DEPTH, D_MODEL)),
        "w1_gate": nrm(ks[3], (DEPTH, D_MODEL, D_FF), D_MODEL),
        "w1_up": nrm(ks[4], (DEPTH, D_MODEL, D_FF), D_MODEL),
        "w1_down": nrm(ks[5], (DEPTH, D_FF, D_MODEL), D_FF),
        "g_mix": gain(ks[6], (DEPTH, D_MODEL)),
        "w_in": nrm(ks[7], (DEPTH, D_MODEL, D_IN), D_MODEL),
        "w_a2_fwd": nrm(ks[8], (DEPTH, GLA_RANK, GLA_QK_W), GLA_RANK),
        "b_a_fwd": 0.1 * jax.random.normal(ks[9], (DEPTH, GLA_QK_W), f32),
        "w_a2_bwd": nrm(ks[10], (DEPTH, GLA_RANK, GLA_QK_W), GLA_RANK),
        "b_a_bwd": 0.1 * jax.random.normal(ks[11], (DEPTH, GLA_QK_W), f32),
        "g_gla_out": gain(ks[12], (DEPTH, GLA_V_W)),
        "w_out": nrm(ks[13], (DEPTH, D_MIX, D_MODEL), D_MIX),
        "g_ffn2": gain(ks[14], (DEPTH, D_MODEL)),
        "w2_gate": nrm(ks[15], (DEPTH, D_MODEL, D_FF), D_MODEL),
        "w2_up": nrm(ks[16], (DEPTH, D_MODEL, D_FF), D_MODEL),
        "w2_down": nrm(ks[17], (DEPTH, D_FF, D_MODEL), D_FF),
        "g_final": gain(ks[18], (D_MODEL,)),
    }


def reference(x_prompt, x_sample, g_ffn1, w1_gate, w1_up, w1_down, g_mix, w_in, w_a2_fwd, b_a_fwd,
              w_a2_bwd, b_a_bwd, g_gla_out, w_out, g_ffn2, w2_gate, w2_up, w2_down, g_final):
    def trunk(x):
        for l in range(DEPTH):
            x = layer(x, g_ffn1[l], w1_gate[l], w1_up[l], w1_down[l], g_mix[l], w_in[l],
                      w_a2_fwd[l], b_a_fwd[l], w_a2_bwd[l], b_a_bwd[l], g_gla_out[l], w_out[l],
                      g_ffn2[l], w2_gate[l], w2_up[l], w2_down[l])
        return rmsnorm(x, g_final)

    y_prompt = trunk(x_prompt)
    y_sample = trunk(x_sample)
    return (y_prompt, y_sample)
```

```cpp
#include <hip/hip_runtime.h>
#include <hip/hip_cooperative_groups.h>
#include <cstdio>
#include <cstdint>
namespace cg = cooperative_groups;
#define PROBE_ATT 1
#define PROBE_G1 1
#define PROBE_G3 1
#define PROBE_PRO 1
#define PROBE_VAR 1
#define PROBE_P1 1
#define ATT_TOUCH 0
#define GLA_TOUCH 0
namespace pg8 {
#define PG8_LAS __attribute__((address_space(3)))
typedef unsigned short bf16_t;
typedef short bf16x8 __attribute__((ext_vector_type(8)));
typedef float f32x4 __attribute__((ext_vector_type(4)));
typedef unsigned u32x4 __attribute__((ext_vector_type(4)));
constexpr int BM = 256, BK = 64, HALF = 128, HTB = HALF * BK * 2  , STAGE_BYTES = 8 * HTB, NXCD = 8, WGM = 8;

__host__ __device__ __forceinline__ int lds_byte(int r, int c) { const int st = (r >> 4) * 2 + (c >> 5), rr = r & 15, cc = c & 31, ob = rr * 64 + cc * 2; return st * 1024 + (ob ^ (((ob >> 9) & 1) << 5)); }
__host__ __device__ __forceinline__ void stage_rc(int b, int& R, int& C) { const int st = b / 1024, sb = b % 1024, swz = sb ^ (((sb >> 9) & 1) << 5); R = (st >> 1) * 16 + swz / 64; C = (st & 1) * 32 + (swz % 64) / 2; }
__host__ __device__ __forceinline__ int perm32(int rho) { const int n = rho >> 4, i = rho & 15; return 8 * (i >> 2) + 4 * n + (i & 3); }

struct Unit { int pm, pn; };
struct Gemm { const bf16_t* A; const bf16_t* Bt; int M, N, K; };

struct StaticOrder {
    int nM, nN, nwg, G, c;
    __host__ __device__ void init(int M, int N, int G_, int c_) { nM = M / BM; nN = N / BM; nwg = nM * nN; G = G_; c = c_; }
    __host__ __device__ bool next(int i, Unit& u) const {
        const long L = (long)i * G + c; if (L >= nwg) return false;
        int wgid = (int)L; { const int q = nwg / NXCD, r = nwg % NXCD, xcd = wgid % NXCD, off = wgid / NXCD; wgid = (xcd < r ? xcd * (q + 1) : r * (q + 1) + (xcd - r) * q) + off; }
        const int nig = WGM * nN, gid = wgid / nig, fm = gid * WGM, gsz = (nM - fm) < WGM ? (nM - fm) : WGM;
        u.pm = fm + ((wgid % nig) % gsz); u.pn = (wgid % nig) / gsz; return true;
    }
    __device__ __forceinline__ void a_ready(const Unit&) const {}
    __device__ __forceinline__ void done(const Unit&) const {}
};
typedef __bf16 bf16x2_hw __attribute__((ext_vector_type(2)));
__device__ __forceinline__ unsigned cvt_pk_bf16(float lo, float hi) { bf16x2_hw v; v[0] = (__bf16)lo; v[1] = (__bf16)hi; return __builtin_bit_cast(unsigned, v); }
template <class Epi, class Sched, bool ALIGN_EPI = false, bool SP2 = false>
__device__ __forceinline__ void gemm_phase(PG8_LAS unsigned char* lds, const Gemm g, const Sched& S, const Epi& E) {
    const int tid = threadIdx.x, wid = __builtin_amdgcn_readfirstlane(tid >> 6), lane = tid & 63, wr = wid >> 2, wc = wid & 3, fr = lane & 15, fq = lane >> 4;
    const int K = g.K, nt = K / BK;
    unsigned voffA[2], voffB[2];
#pragma unroll
    for (int i = 0; i < 2; ++i) { int R, C; stage_rc(tid * 16 + i * 8192, R, C); const int Rb = Epi::PERM ? ((R & ~31) + perm32(R & 31)) : R;
        voffA[i] = (unsigned)(R * K + C) * 2u; voffB[i] = (unsigned)(Rb * K + C) * 2u; }
    const size_t kstep = (size_t)(BK * 2);
    const size_t hstep = (size_t)HALF * K * 2;
    const size_t tstep = 2 * hstep;
    const unsigned ldsw = (unsigned)wid * 1024u;
    const int aoff = lds_byte(wr * 64 + fr, fq * 8), boff = lds_byte(wc * 32 + fr, fq * 8);
#define PG8_SA(b, h) (((b) * 2 + (h)) * HTB)
#define PG8_SB(b, h) ((4 + (b) * 2 + (h)) * HTB)
#define PG8_STAGE(bufoff, gbase, voff) do { _Pragma("unroll") for (int _i = 0; _i < 2; ++_i) \
        __builtin_amdgcn_global_load_lds((const unsigned*)((const char*)(gbase) + (voff)[_i]), (PG8_LAS unsigned*)(lds + (bufoff) + ldsw + _i * 8192), 16, 0, 0); } while (0)
#define PG8_LDA(dst, b, h) do { _Pragma("unroll") for (int m = 0; m < 4; ++m) _Pragma("unroll") for (int k = 0; k < 2; ++k) dst[m][k] = *(const PG8_LAS bf16x8*)(lds + PG8_SA(b, h) + aoff + m * 2048 + k * 1024); } while (0)
#define PG8_LDB(dst, b, h) do { _Pragma("unroll") for (int n = 0; n < 2; ++n) _Pragma("unroll") for (int k = 0; k < 2; ++k) dst[n][k] = *(const PG8_LAS bf16x8*)(lds + PG8_SB(b, h) + boff + n * 2048 + k * 1024); } while (0)
#define PG8_MMA(ai, bj, At, Bt) do { __builtin_amdgcn_s_setprio(1); _Pragma("unroll") for (int m = 0; m < 4; ++m) _Pragma("unroll") for (int n = 0; n < 2; ++n) _Pragma("unroll") for (int k = 0; k < 2; ++k) \
        acc[ai][bj][m][n] = __builtin_amdgcn_mfma_f32_16x16x32_bf16(Bt[n][k], At[m][k], acc[ai][bj][m][n], 0, 0, 0); __builtin_amdgcn_s_setprio(0); } while (0)
#define PG8_WAIT_V(n) asm volatile("s_waitcnt vmcnt(" #n ")" ::: "memory")
#define PG8_WAIT_L(n) asm volatile("s_waitcnt lgkmcnt(" #n ")" ::: "memory")
#define PG8_BAR __builtin_amdgcn_s_barrier()
#define PG8_SCHED __builtin_amdgcn_sched_barrier(0)
    Unit cur, nxt; int ui = 0;
    if (!S.next(0, cur)) return;
    f32x4 acc[2][2][4][2];
#pragma unroll
    for (int a = 0; a < 2; ++a)
#pragma unroll
        for (int b = 0; b < 2; ++b)
#pragma unroll
            for (int m = 0; m < 4; ++m)
#pragma unroll
                for (int n = 0; n < 2; ++n) acc[a][b][m][n] = (f32x4){0.f, 0.f, 0.f, 0.f};
    bf16x8 At[4][2], B0[2][2], B1[2][2];
    const char* cA = (const char*)g.A + (size_t)cur.pm * tstep; const char* cB = (const char*)g.Bt + (size_t)cur.pn * tstep;
    S.a_ready(cur);
    if constexpr (SP2) {
        PG8_STAGE(PG8_SB(0, 0), cB, voffB); PG8_STAGE(PG8_SB(0, 1), cB + hstep, voffB); PG8_STAGE(PG8_SA(0, 0), cA, voffA); PG8_STAGE(PG8_SA(0, 1), cA + hstep, voffA);
        if (wr == 1) PG8_BAR;
        PG8_WAIT_V(2); PG8_BAR;
        PG8_STAGE(PG8_SB(1, 0), cB + kstep, voffB); PG8_STAGE(PG8_SA(1, 0), cA + kstep, voffA); PG8_STAGE(PG8_SB(1, 1), cB + hstep + kstep, voffB);
        PG8_WAIT_V(6); PG8_BAR;
    } else {
        PG8_STAGE(PG8_SB(0, 0), cB, voffB); PG8_STAGE(PG8_SA(0, 0), cA, voffA); PG8_STAGE(PG8_SB(0, 1), cB + hstep, voffB); PG8_STAGE(PG8_SA(0, 1), cA + hstep, voffA);
        if (wr == 1) PG8_BAR;
        PG8_WAIT_V(4); PG8_BAR;
        PG8_STAGE(PG8_SB(1, 0), cB + kstep, voffB); PG8_STAGE(PG8_SA(1, 0), cA + kstep, voffA); PG8_STAGE(PG8_SB(1, 1), cB + hstep + kstep, voffB);
        PG8_WAIT_V(6); PG8_BAR;
    }
    for (;;) {
        const bool has_next = S.next(ui + 1, nxt);
        const char* nA = has_next ? (const char*)g.A + (size_t)nxt.pm * tstep : cA; const char* nB = has_next ? (const char*)g.Bt + (size_t)nxt.pn * tstep : cB;
        for (int t = 0; t < nt; t += 2) {
            const bool last = (t == nt - 2);
            const char* a1 = cA + (size_t)(t + 1) * kstep;
            const char* a2 = last ? nA : cA + (size_t)(t + 2) * kstep; const char* b2 = last ? nB : cB + (size_t)(t + 2) * kstep;
            const char* a3 = a2 + kstep; const char* b3 = b2 + kstep;
            if (last && has_next) S.a_ready(nxt);
            if constexpr (SP2) {
            PG8_LDB(B0, 0, 0); PG8_LDB(B1, 0, 1); PG8_SCHED; PG8_LDA(At, 0, 0); PG8_STAGE(PG8_SA(1, 1), a1 + hstep, voffA);
            PG8_WAIT_V(8); PG8_WAIT_L(0); PG8_BAR; PG8_MMA(0, 0, At, B0); PG8_MMA(0, 1, At, B1); PG8_BAR; PG8_SCHED;
            PG8_LDA(At, 0, 1); PG8_STAGE(PG8_SB(0, 0), b2, voffB); PG8_STAGE(PG8_SB(0, 1), b2 + hstep, voffB); PG8_STAGE(PG8_SA(0, 0), a2, voffA);
            PG8_WAIT_V(8); PG8_WAIT_L(0); PG8_BAR; PG8_MMA(1, 0, At, B0); PG8_MMA(1, 1, At, B1); PG8_BAR; PG8_SCHED;
            PG8_LDB(B0, 1, 0); PG8_LDB(B1, 1, 1); PG8_SCHED; PG8_LDA(At, 1, 0); PG8_STAGE(PG8_SA(0, 1), a2 + hstep, voffA);
            PG8_WAIT_V(8); PG8_WAIT_L(0); PG8_BAR; PG8_MMA(0, 0, At, B0); PG8_MMA(0, 1, At, B1); PG8_BAR; PG8_SCHED;
            PG8_LDA(At, 1, 1); PG8_STAGE(PG8_SB(1, 0), b3, voffB); PG8_STAGE(PG8_SB(1, 1), b3 + hstep, voffB); PG8_STAGE(PG8_SA(1, 0), a3, voffA);
            PG8_WAIT_V(8); PG8_WAIT_L(0); PG8_BAR; PG8_MMA(1, 0, At, B0); PG8_MMA(1, 1, At, B1); PG8_BAR; PG8_SCHED;
            } else {
            PG8_LDB(B0, 0, 0); PG8_SCHED; PG8_LDA(At, 0, 0); PG8_STAGE(PG8_SA(1, 1), a1 + hstep, voffA);
            PG8_WAIT_L(8); PG8_BAR; PG8_WAIT_L(0); PG8_MMA(0, 0, At, B0); PG8_BAR; PG8_SCHED;
            PG8_LDB(B1, 0, 1); PG8_STAGE(PG8_SB(0, 0), b2, voffB);
            PG8_BAR; PG8_WAIT_L(0); PG8_MMA(0, 1, At, B1); PG8_BAR;
            PG8_LDA(At, 0, 1); PG8_STAGE(PG8_SA(0, 0), a2, voffA);
            PG8_BAR; PG8_WAIT_L(0); PG8_MMA(1, 0, At, B0); PG8_BAR; PG8_SCHED;
            PG8_STAGE(PG8_SB(0, 1), b2 + hstep, voffB);
            PG8_WAIT_V(6); PG8_BAR; PG8_MMA(1, 1, At, B1); PG8_BAR;
            PG8_LDB(B0, 1, 0); PG8_SCHED; PG8_LDA(At, 1, 0); PG8_STAGE(PG8_SA(0, 1), a2 + hstep, voffA);
            PG8_WAIT_L(8); PG8_BAR; PG8_WAIT_L(0); PG8_MMA(0, 0, At, B0); PG8_BAR; PG8_SCHED;
            PG8_LDB(B1, 1, 1); PG8_STAGE(PG8_SB(1, 0), b3, voffB);
            PG8_BAR; PG8_WAIT_L(0); PG8_MMA(0, 1, At, B1); PG8_BAR;
            PG8_LDA(At, 1, 1); PG8_STAGE(PG8_SA(1, 0), a3, voffA);
            PG8_BAR; PG8_WAIT_L(0); PG8_MMA(1, 0, At, B0); PG8_BAR; PG8_SCHED;
            PG8_STAGE(PG8_SB(1, 1), b3 + hstep, voffB);
            PG8_WAIT_V(6); PG8_BAR; PG8_MMA(1, 1, At, B1); PG8_BAR;
            }
        }
        if constexpr (ALIGN_EPI) { if (wr == 0) PG8_BAR; }
        if constexpr (!Epi::AFTER_DRAIN) { E(acc, cur, wr, wc, fr, fq); S.done(cur); }
        if (!has_next) break;
#pragma unroll
        for (int a = 0; a < 2; ++a)
#pragma unroll
            for (int b = 0; b < 2; ++b)
#pragma unroll
                for (int m = 0; m < 4; ++m)
#pragma unroll
                    for (int n = 0; n < 2; ++n) acc[a][b][m][n] = (f32x4){0.f, 0.f, 0.f, 0.f};
        cur = nxt; cA = nA; cB = nB; ++ui;
        if constexpr (ALIGN_EPI) { if (wr == 1) PG8_BAR; }
    }
    PG8_WAIT_V(0);
    if constexpr (!ALIGN_EPI) { if (wr == 0) PG8_BAR; }
    PG8_BAR;
    if constexpr (Epi::AFTER_DRAIN) { E.fused(acc, cur, wr, wc, fr, fq, lds, wid, lane); S.done(cur); }
#undef PG8_SA
#undef PG8_SB
#undef PG8_STAGE
#undef PG8_LDA
#undef PG8_LDB
#undef PG8_MMA
#undef PG8_WAIT_V
#undef PG8_WAIT_L
#undef PG8_BAR
#undef PG8_SCHED
}
}
using pg8::bf16_t; using pg8::bf16x8; using pg8::f32x4; using pg8::u32x4; using pg8::Unit; using pg8::cvt_pk_bf16;
#define LAS __attribute__((address_space(3)))
typedef unsigned u32x2 __attribute__((ext_vector_type(2)));
typedef short s16x4 __attribute__((ext_vector_type(4)));

constexpr int MTOK = 81920, MPROMPT = 65536, DM = 1024, DFF = 2816, NGU = 5632, NZC = 3104  , NZ = 3136  , NZP = 3328;
constexpr int ZQ = 0, ZK = 256, ZV = 512, ZR = 1024, ZAQ = 1536, ZAK = 2048, ZAV = 2560, ZLF = 3072, ZLB = 3088;
constexpr int NCHUNK = 1280;
constexpr float EPS = 1e-6f, LOG2E = 1.4426950408889634f;
constexpr size_t MiB = 1u << 20;
constexpr size_t WS_SSQ = 0, WS_DEC = 2 * MiB, WS_W1GU = 5 * MiB, WS_W1D = 16 * MiB, WS_W2GU = 22 * MiB, WS_W2D = 33 * MiB, WS_WIN = 39 * MiB, WS_WOUT = 46 * MiB,
                 WS_ACTA = 48 * MiB, WS_ST = 208 * MiB, WS_BIG = 368 * MiB, WS_DUMMY = 860 * MiB, WS_BAR = 862 * MiB, WS_END = 863 * MiB;
constexpr int LDS_BYTES = 147456;
constexpr int NTHREADS = 512;

struct Params { const float* in[19]; float* out; unsigned char* ws; };

__device__ __forceinline__ int ltid() { int t = threadIdx.x; asm volatile("" : "+v"(t)); return t; }
__device__ __forceinline__ float bf2f(unsigned short b) { return __uint_as_float((unsigned)b << 16); }
__device__ __forceinline__ unsigned short f2bf(float f) { unsigned u = __float_as_uint(f); return (unsigned short)((u + 0x7fffu + ((u >> 16) & 1u)) >> 16); }
__device__ __forceinline__ float wave_sum(float v) {
#pragma unroll
    for (int o = 1; o < 64; o <<= 1) v += __shfl_xor(v, o);
    return v;
}
__device__ __forceinline__ float quad_max(float x) {
    auto a = __builtin_amdgcn_permlane16_swap(__float_as_uint(x), __float_as_uint(x), false, false); x = fmaxf(__uint_as_float(a[0]), __uint_as_float(a[1]));
    auto b = __builtin_amdgcn_permlane32_swap(__float_as_uint(x), __float_as_uint(x), false, false); return fmaxf(__uint_as_float(b[0]), __uint_as_float(b[1]));
}
__device__ __forceinline__ float quad_sum(float x) {
    auto a = __builtin_amdgcn_permlane16_swap(__float_as_uint(x), __float_as_uint(x), false, false); x = __uint_as_float(a[0]) + __uint_as_float(a[1]);
    auto b = __builtin_amdgcn_permlane32_swap(__float_as_uint(x), __float_as_uint(x), false, false); return __uint_as_float(b[0]) + __uint_as_float(b[1]);
}
__device__ __forceinline__ void lds_barrier() { asm volatile("s_waitcnt lgkmcnt(0)" ::: "memory"); __builtin_amdgcn_s_barrier(); asm volatile("" ::: "memory"); }
#define LDS_WAIT() asm volatile("s_waitcnt lgkmcnt(0)" ::: "memory")

__device__ __forceinline__ void transpose_item(const float* W, int K, int N, bf16_t* WT, int mode, const float* gk, LAS float* scr, int item, int lane) {
    const int nblk = N / 32, kb = item / nblk, nb = item % nblk, k0 = 64 * kb, n0 = 32 * nb;
#pragma unroll 8
    for (int i = 0; i < 32; ++i) { const int kk = 2 * i + (lane >> 5); const float g = gk ? gk[k0 + kk] : 1.0f; scr[kk * 33 + (lane & 31)] = W[(size_t)(k0 + kk) * N + n0 + (lane & 31)] * g; }
    LDS_WAIT(); asm volatile("" ::: "memory");
    const int c = lane & 7;
#pragma unroll
    for (int j = 0; j < 4; ++j) {
        const int n = (lane >> 3) + 8 * j, ns = n0 + n; int drow = ns; float rs = 1.0f;
        if (mode == 1) drow = (ns >> 2) * 8 + (ns & 3);
        else if (mode == 2) drow = (ns >> 2) * 8 + 4 + (ns & 3);
        else if (mode == 3) { drow = ns < 1536 ? ns : (ns < 1568 ? ns + 1536 : ns - 32); if (ns < 256) rs = 0.125f; else if (ns >= 1568 && ns < 2080) rs = 0.125f * LOG2E; }
        const LAS float* s = scr + (8 * c) * 33 + n;
        u32x4 o; o.x = cvt_pk_bf16(s[0 * 33] * rs, s[1 * 33] * rs); o.y = cvt_pk_bf16(s[2 * 33] * rs, s[3 * 33] * rs); o.z = cvt_pk_bf16(s[4 * 33] * rs, s[5 * 33] * rs); o.w = cvt_pk_bf16(s[6 * 33] * rs, s[7 * 33] * rs);
        *(u32x4*)(WT + (size_t)drow * K + k0 + 8 * c) = o;
    }
    LDS_WAIT(); asm volatile("" ::: "memory");
}

__device__ __forceinline__ void prologue(const Params& p, LAS unsigned char* lds) {
    const int tid = ltid(), lane = tid & 63, wave = tid >> 6;
    const int gw = blockIdx.x * 8 + wave, NGW = gridDim.x * 8;
    LAS float* scr = (LAS float*)(lds + wave * 8704);
    unsigned char* ws = p.ws;
    constexpr int I_GU = (DM / 64) * (DFF / 32), I_D = (DFF / 64) * (DM / 32);
    constexpr int NITEMS = 2 * I_GU + I_D;
    for (int it = gw; it < NITEMS; it += NGW) {
        int r = it;
        if (r < I_GU) { transpose_item(p.in[3], DM, DFF, (bf16_t*)(ws + WS_W1GU), 1, p.in[2], scr, r, lane); continue; } r -= I_GU;
        if (r < I_GU) { transpose_item(p.in[4], DM, DFF, (bf16_t*)(ws + WS_W1GU), 2, p.in[2], scr, r, lane); continue; } r -= I_GU;
        transpose_item(p.in[5], DFF, DM, (bf16_t*)(ws + WS_W1D), 0, nullptr, scr, r, lane);
    }
    float* ssq = (float*)(ws + WS_SSQ); bf16_t* xb = (bf16_t*)(ws + WS_ACTA);
    for (int row = gw; row < MTOK; row += 2 * NGW) {
        const int row2 = row + NGW; const bool has2 = row2 < MTOK;
        const float* xr = row < MPROMPT ? p.in[0] + (size_t)row * DM : p.in[1] + (size_t)(row - MPROMPT) * DM;
        const float* xr2 = !has2 ? xr : (row2 < MPROMPT ? p.in[0] + (size_t)row2 * DM : p.in[1] + (size_t)(row2 - MPROMPT) * DM);
        f32x4 v[4], v2[4]; float s = 0.f, s2 = 0.f;
#pragma unroll
        for (int j = 0; j < 4; ++j) { v[j] = ((const f32x4*)xr)[lane + 64 * j]; v2[j] = ((const f32x4*)xr2)[lane + 64 * j]; }
#pragma unroll
        for (int j = 0; j < 4; ++j) { s += (v[j].x * v[j].x + v[j].y * v[j].y) + (v[j].z * v[j].z + v[j].w * v[j].w); s2 += (v2[j].x * v2[j].x + v2[j].y * v2[j].y) + (v2[j].z * v2[j].z + v2[j].w * v2[j].w); }
        s = wave_sum(s); s2 = wave_sum(s2);
#pragma unroll
        for (int j = 0; j < 4; ++j) { u32x2 o; o.x = cvt_pk_bf16(v[j].x, v[j].y); o.y = cvt_pk_bf16(v[j].z, v[j].w); ((u32x2*)(xb + (size_t)row * DM))[lane + 64 * j] = o; }
        if (lane == 0) ssq[row] = s;
        if (has2) {
#pragma unroll
            for (int j = 0; j < 4; ++j) { u32x2 o; o.x = cvt_pk_bf16(v2[j].x, v2[j].y); o.y = cvt_pk_bf16(v2[j].z, v2[j].w); ((u32x2*)(xb + (size_t)row2 * DM))[lane + 64 * j] = o; }
            if (lane == 0) ssq[row2] = s2; }
    }
    const int gt = blockIdx.x * NTHREADS + tid, NGT = gridDim.x * NTHREADS;
    for (int i = gt; i < 3 * MTOK / 4; i += NGT) ((f32x4*)(ssq + MTOK))[i] = (f32x4){0.f, 0.f, 0.f, 0.f};
    u32x4* padp = (u32x4*)((bf16_t*)(ws + WS_WIN) + (size_t)NZC * DM);
    for (int i = gt; i < (NZP - NZC) * DM / 8; i += NGT) padp[i] = (u32x4){0u, 0u, 0u, 0u};
}

__device__ __forceinline__ void deferred_weights(const Params& p, LAS unsigned char* lds, int widx, int nw) {
    const int tid = ltid(), lane = tid & 63, wave = tid >> 6;
    LAS float* scr = (LAS float*)(lds + wave * 8704);
    unsigned char* ws = p.ws;
    constexpr int I_GU = (DM / 64) * (DFF / 32), I_D = (DFF / 64) * (DM / 32), I_IN = (DM / 64) * (NZC / 32), I_OUT = (DM / 64) * (DM / 32);
    constexpr int NITEMS = 2 * I_GU + I_D + I_IN + I_OUT;
    for (int it = widx; it < NITEMS; it += nw) {
        int r = it;
        if (r < I_IN) { transpose_item(p.in[7], DM, NZC, (bf16_t*)(ws + WS_WIN), 3, p.in[6], scr, r, lane); continue; } r -= I_IN;
        if (r < I_OUT) { transpose_item(p.in[13], DM, DM, (bf16_t*)(ws + WS_WOUT), 0, nullptr, scr, r, lane); continue; } r -= I_OUT;
        if (r < I_GU) { transpose_item(p.in[15], DM, DFF, (bf16_t*)(ws + WS_W2GU), 1, p.in[14], scr, r, lane); continue; } r -= I_GU;
        if (r < I_GU) { transpose_item(p.in[16], DM, DFF, (bf16_t*)(ws + WS_W2GU), 2, p.in[14], scr, r, lane); continue; } r -= I_GU;
        transpose_item(p.in[17], DFF, DM, (bf16_t*)(ws + WS_W2D), 0, nullptr, scr, r, lane);
    }
}

__device__ __forceinline__ void lr_gemm_item(const bf16_t* A, const bf16_t* Wt  , const float* ssq, bf16_t* Z, LAS unsigned char* lds, int item) {
    const int tid = ltid(), lane = tid & 63, wave = tid >> 6, fr = lane & 15, quad = lane >> 4; const int row0 = item * 64, k0 = wave * 128 + quad * 8;
    bf16x8 a[4][4], bw[2][4];
#pragma unroll
    for (int rt = 0; rt < 4; ++rt)
#pragma unroll
        for (int ks = 0; ks < 4; ++ks) a[rt][ks] = *(const bf16x8*)(A + (size_t)(row0 + rt * 16 + fr) * DM + k0 + ks * 32);
#pragma unroll
    for (int ct = 0; ct < 2; ++ct)
#pragma unroll
        for (int ks = 0; ks < 4; ++ks) bw[ct][ks] = *(const bf16x8*)(Wt + (size_t)(ct * 16 + fr) * DM + k0 + ks * 32);
    LAS float* part = (LAS float*)lds;
#pragma unroll
    for (int rt = 0; rt < 4; ++rt)
#pragma unroll
        for (int ct = 0; ct < 2; ++ct) { f32x4 acc = {0.f, 0.f, 0.f, 0.f};
#pragma unroll
            for (int ks = 0; ks < 4; ++ks) acc = __builtin_amdgcn_mfma_f32_16x16x32_bf16(a[rt][ks], bw[ct][ks], acc, 0, 0, 0);
#pragma unroll
            for (int j = 0; j < 4; ++j) part[(wave * 64 + rt * 16 + quad * 4 + j) * 32 + ct * 16 + fr] = acc[j]; }
    lds_barrier();
    { const int r = tid >> 3, c4 = (tid & 7) * 4; f32x4 s = {0.f, 0.f, 0.f, 0.f};
#pragma unroll
      for (int w = 0; w < 8; ++w) s += *(const LAS f32x4*)(part + (w * 64 + r) * 32 + c4);
      const float rs = rsqrtf(ssq[row0 + r] * (1.0f / DM) + EPS);
      u32x2 o; o.x = cvt_pk_bf16(s[0] * rs, s[1] * rs); o.y = cvt_pk_bf16(s[2] * rs, s[3] * rs);
      *(u32x2*)(Z + (size_t)(row0 + r) * NZ + ZLF + c4) = o; }
    lds_barrier();
}

struct EpiSwiglu {
    static constexpr bool PERM = true, AFTER_DRAIN = false;
    bf16_t* H; const float* ssq;
    __device__ __forceinline__ void operator()(const f32x4 (&acc)[2][2][4][2], const Unit& u, int wr, int wc, int fr, int fq) const {
        const int row0 = u.pm * 256 + wr * 64 + fr, hc0 = u.pn * 128 + wc * 16 + 4 * fq;
        const int hcs = (fq & 1) ? hc0 + 60 : hc0;
#pragma unroll
        for (int ai = 0; ai < 2; ++ai)
#pragma unroll
            for (int m = 0; m < 4; ++m) {
                const int row = row0 + ai * 128 + m * 16; const float rs = rsqrtf(ssq[row] * (1.0f / DM) + EPS), nrl = -LOG2E * rs, rs2 = rs * rs;
                u32x2 o[2];
#pragma unroll
                for (int bj = 0; bj < 2; ++bj) {
                    const f32x4 ga = acc[ai][bj][m][0], ua = acc[ai][bj][m][1]; float hv[4];
#pragma unroll
                    for (int j = 0; j < 4; ++j) hv[j] = (ga[j] * ua[j]) * (rs2 * __builtin_amdgcn_rcpf(1.0f + __builtin_amdgcn_exp2f(nrl * ga[j])));
                    o[bj].x = cvt_pk_bf16(hv[0], hv[1]); o[bj].y = cvt_pk_bf16(hv[2], hv[3]);
                }
                const auto rx = __builtin_amdgcn_permlane16_swap(o[0].x, o[1].x, false, false), ry = __builtin_amdgcn_permlane16_swap(o[0].y, o[1].y, false, false);
                u32x4 w; w.x = rx[0]; w.y = ry[0]; w.z = rx[1]; w.w = ry[1];
                *(u32x4*)(H + (size_t)row * DFF + hcs) = w;
            }
    }
};
template <bool BASE_BF16> struct EpiResid {
    static constexpr bool PERM = true, AFTER_DRAIN = false;
    const float* base0; const float* base1; int split; const bf16_t* baseb; bf16_t* ob; float* ssq; float alpha;
    __device__ __forceinline__ void operator()(const f32x4 (&acc)[2][2][4][2], const Unit& u, int wr, int wc, int fr, int fq) const {
        const int row0 = u.pm * 256 + wr * 64 + fr, c00 = u.pn * 256 + wc * 32 + 8 * fq;
        float ssum[2][4];
#pragma unroll
        for (int ai = 0; ai < 2; ++ai)
#pragma unroll
            for (int m = 0; m < 4; ++m) {
                const int row = row0 + ai * 128 + m * 16;
                float s = 0.f;
#pragma unroll
                for (int bj = 0; bj < 2; ++bj) {
                    const int c0 = c00 + bj * 128; f32x4 b0, b1;
                    if constexpr (BASE_BF16) { const u32x4 r = *(const u32x4*)(baseb + (size_t)row * DM + c0);
                        b0 = (f32x4){__uint_as_float(r.x << 16), __uint_as_float(r.x & 0xffff0000u), __uint_as_float(r.y << 16), __uint_as_float(r.y & 0xffff0000u)};
                        b1 = (f32x4){__uint_as_float(r.z << 16), __uint_as_float(r.z & 0xffff0000u), __uint_as_float(r.w << 16), __uint_as_float(r.w & 0xffff0000u)};
                    } else { const float* b = row < split ? base0 + (size_t)row * DM : base1 + (size_t)(row - split) * DM; b0 = *(const f32x4*)(b + c0); b1 = *(const f32x4*)(b + c0 + 4); }
                    const f32x4 v0 = b0 + acc[ai][bj][m][0] * alpha, v1 = b1 + acc[ai][bj][m][1] * alpha;
                    u32x4 w; w.x = cvt_pk_bf16(v0[0], v0[1]); w.y = cvt_pk_bf16(v0[2], v0[3]); w.z = cvt_pk_bf16(v1[0], v1[1]); w.w = cvt_pk_bf16(v1[2], v1[3]); *(u32x4*)(ob + (size_t)row * DM + c0) = w;
                    s += (v0[0] * v0[0] + v0[1] * v0[1]) + (v0[2] * v0[2] + v0[3] * v0[3]) + (v1[0] * v1[0] + v1[1] * v1[1]) + (v1[2] * v1[2] + v1[3] * v1[3]);
                }
                ssum[ai][m] = quad_sum(s);
            }
#pragma unroll
        for (int ai = 0; ai < 2; ++ai) { const float v = fq == 0 ? ssum[ai][0] : fq == 1 ? ssum[ai][1] : fq == 2 ? ssum[ai][2] : ssum[ai][3];
            atomicAdd(ssq + row0 + ai * 128 + fq * 16, v); }
    }
};
struct EpiZ {
    static constexpr bool PERM = true, AFTER_DRAIN = false;
    bf16_t* Z; const float* ssq;
    __device__ __forceinline__ void operator()(const f32x4 (&acc)[2][2][4][2], const Unit& u, int wr, int wc, int fr, int fq) const {
        const int row0 = u.pm * 256 + wr * 64 + fr, c00 = u.pn * 256 + wc * 32 + 8 * fq;
#pragma unroll
        for (int ai = 0; ai < 2; ++ai)
#pragma unroll
            for (int m = 0; m < 4; ++m) {
                const int row = row0 + ai * 128 + m * 16; const float rs = rsqrtf(ssq[row] * (1.0f / DM) + EPS);
#pragma unroll
                for (int bj = 0; bj < 2; ++bj) {
                    const int c0 = c00 + bj * 128;
                    if (c0 < NZC) { const f32x4 v0 = acc[ai][bj][m][0] * rs, v1 = acc[ai][bj][m][1] * rs;
                        u32x4 w; w.x = cvt_pk_bf16(v0[0], v0[1]); w.y = cvt_pk_bf16(v0[2], v0[3]); w.z = cvt_pk_bf16(v1[0], v1[1]); w.w = cvt_pk_bf16(v1[2], v1[3]);
                        *(u32x4*)(Z + (size_t)row * NZ + c0) = w; }
                }
            }
    }
};
#define XB_TMO      128
#define XB_XCNT(j)  (256  + 64 * (j))
#define XB_XSUB(j)  (1280 + 64 * (j))
#define XB_XGEN(j)  (2304 + 64 * (j))
#define XB_TOP      3328
#define XB_TOPGEN   3392
#define XCD_BAR_WORDS 3456
#define XB_SPIN_CAP (1u << 18)

__device__ __forceinline__ unsigned xb_ld(unsigned* p)              { return __hip_atomic_load(p, __ATOMIC_RELAXED, __HIP_MEMORY_SCOPE_AGENT); }
__device__ __forceinline__ unsigned xb_add(unsigned* p, unsigned v) { return __hip_atomic_fetch_add(p, v, __ATOMIC_RELAXED, __HIP_MEMORY_SCOPE_AGENT); }
__device__ __forceinline__ unsigned xb_xcc_id() { return (unsigned)__builtin_amdgcn_s_getreg((3 << 11) | 20) & 0xFu; }
#define XB_SPIN(cond, bar) do { unsigned _sp = 0; while (cond) { __builtin_amdgcn_s_sleep(1); \
    if ((++_sp & 255u) == 0u) { if (xb_ld(&(bar)[XB_TMO])) break; if (_sp > XB_SPIN_CAP) { atomicAdd(&(bar)[XB_TMO], 1u); break; } } } } while (0)

struct XcdBarrier {
    unsigned* bar; unsigned x;
    volatile LAS unsigned* st;
};

__device__ __forceinline__ XcdBarrier xcd_barrier_post(unsigned* bar, volatile LAS unsigned* st) {
    XcdBarrier b; b.bar = bar; b.x = xb_xcc_id(); b.st = st;
    if (threadIdx.x == 0) (void)xb_add(&bar[XB_XCNT(b.x)], 1u);
    return b;
}
__device__ __forceinline__ void xcd_barrier_complete(unsigned* bar, unsigned x, unsigned& nloc, unsigned& nx) {
    const unsigned G = gridDim.x * gridDim.y * gridDim.z;
    unsigned sum, cnt, mine, sp = 0u;
    for (;;) {
        sum = 0u; cnt = 0u; mine = 0u;
#pragma unroll
        for (unsigned j = 0; j < 16; ++j) { const unsigned c = xb_ld(&bar[XB_XCNT(j)]); sum += c; cnt += (c > 0u) ? 1u : 0u; mine = (j == x) ? c : mine; }
        if (sum == G) break;
        __builtin_amdgcn_s_sleep(1);
        if ((++sp & 255u) == 0u) { if (xb_ld(&bar[XB_TMO])) break; if (sp > XB_SPIN_CAP) { atomicAdd(&bar[XB_TMO], 1u); break; } }
    }
    nloc = mine > 0u ? mine : 1u; nx = cnt > 0u ? cnt : 1u;
}

__device__ __forceinline__ void xcd_barrier(const XcdBarrier& b) {
    asm volatile("s_waitcnt vmcnt(0)" ::: "memory");
    __syncthreads();
    if (threadIdx.x == 0) {
        unsigned* bar = b.bar;
        __builtin_amdgcn_s_waitcnt(0);
        unsigned nloc = b.st[0], nx = b.st[1];
        if (nloc == 0u) { xcd_barrier_complete(bar, b.x, nloc, nx); b.st[0] = nloc; b.st[1] = nx; }
        const unsigned old = xb_add(&bar[XB_XSUB(b.x)], 1u);
        const unsigned gen = old / nloc;
        if (old + 1u == (gen + 1u) * nloc) {
            __builtin_amdgcn_fence(__ATOMIC_RELEASE, "agent");
            asm volatile("s_waitcnt vmcnt(0)" ::: "memory");
            const unsigned og = xb_add(&bar[XB_TOP], 1u);
            const unsigned tg = og / nx;
            if (og + 1u == (tg + 1u) * nx) xb_add(&bar[XB_TOPGEN], 1u);
            else XB_SPIN(xb_ld(&bar[XB_TOPGEN]) == tg, bar);
            __builtin_amdgcn_fence(__ATOMIC_ACQUIRE, "agent");
            xb_add(&bar[XB_XGEN(b.x)], 1u);
            asm volatile("s_waitcnt vmcnt(0)" ::: "memory");
        } else {
            XB_SPIN(xb_ld(&bar[XB_XGEN(b.x)]) == gen, bar);
            __builtin_amdgcn_fence(__ATOMIC_ACQUIRE, "agent");
            asm volatile("s_waitcnt vmcnt(0)" ::: "memory");
        }
    }
    __syncthreads();
}

#define MFMA16(a, b, c) __builtin_amdgcn_mfma_f32_16x16x32_bf16((a), (b), (c), 0, 0, 0)
typedef __bf16 bf2_t __attribute__((ext_vector_type(2)));
__device__ __forceinline__ float dot2bf(unsigned a, unsigned b, float c) { return __builtin_amdgcn_fdot2_f32_bf16(__builtin_bit_cast(bf2_t, a), __builtin_bit_cast(bf2_t, b), c, false); }
__device__ __forceinline__ bf16_t f2bf1(float x) { return (bf16_t)cvt_pk_bf16(x, 0.f); }
constexpr int GL_LR = 0  , GL_WA = 8192, GL_BA = 16384, GL_TOT = 16896, GL_VT = 18944  , GL_A = 37376  , GL_P = 74240  , GL_SS = 83456  , GL_KR = 85504  , GL_QR = 94720  ;

__device__ __forceinline__ void gla_load(const Params& p, const bf16_t* Z, LAS unsigned char* lds, int gc, int h, bool withq) {
    const int tid = ltid(); const size_t tok0 = (size_t)gc * 64;
    LAS unsigned* lr = (LAS unsigned*)(lds + GL_LR); LAS float* wa = (LAS float*)(lds + GL_WA); LAS float* ba = (LAS float*)(lds + GL_BA); LAS bf16_t* vT = (LAS bf16_t*)(lds + GL_VT);
    { const int t = tid >> 3, r4 = (tid & 7) * 4; const u32x2 raw = *(const u32x2*)(Z + (tok0 + t) * NZ + ZLF + r4);
      *(LAS u32x2*)(lr + ((r4 >> 4) * 64 + t) * 8 + ((r4 & 15) >> 1)) = raw; }
    { const int dir = tid >> 8, r = (tid >> 4) & 15, kk4 = (tid & 15) * 4; const float* src = (dir ? p.in[10] : p.in[8]) + r * 256 + h * 64 + kk4;
      *(LAS f32x4*)(wa + (dir * 16 + r) * 64 + kk4) = *(const f32x4*)src; }
    { const int t = tid >> 3, k8 = (tid & 7) * 8;
      *(LAS u32x4*)(lds + GL_KR + (t * 72 + k8) * 2) = *(const u32x4*)(Z + (tok0 + t) * NZ + ZK + h * 64 + k8);
      if (withq) *(LAS u32x4*)(lds + GL_QR + (t * 72 + k8) * 2) = *(const u32x4*)(Z + (tok0 + t) * NZ + ZQ + h * 64 + k8); }
    if (tid < 128) { const int dir = tid >> 6, kk = tid & 63; ba[dir * 64 + kk] = (dir ? p.in[11] : p.in[9])[h * 64 + kk]; }
    { const int t = tid >> 3, dv0 = (tid & 7) * 16; const u32x4* src = (const u32x4*)(Z + (tok0 + t) * NZ + ZV + h * 128 + dv0); const u32x4 a = src[0], b = src[1];
      const unsigned wv[8] = {a.x, a.y, a.z, a.w, b.x, b.y, b.z, b.w};
#pragma unroll
      for (int e = 0; e < 8; ++e) { vT[(dv0 + 2 * e) * 72 + t] = (bf16_t)(wv[e] & 0xffffu); vT[(dv0 + 2 * e + 1) * 72 + t] = (bf16_t)(wv[e] >> 16); } }
    __syncthreads();
}
__device__ __forceinline__ void gla_gates(LAS unsigned char* lds, float (&c)[16], float (&la)[16], float& off, float& all) {
    const int tid = ltid(), dir = tid >> 8, qtr = (tid >> 6) & 3, kk = tid & 63;
    LAS unsigned* lr = (LAS unsigned*)(lds + GL_LR); LAS float* wa = (LAS float*)(lds + GL_WA); LAS float* ba = (LAS float*)(lds + GL_BA); LAS float* tot = (LAS float*)(lds + GL_TOT);
    unsigned w2[8];
#pragma unroll
    for (int r = 0; r < 8; ++r) w2[r] = cvt_pk_bf16(wa[(dir * 16 + 2 * r) * 64 + kk], wa[(dir * 16 + 2 * r + 1) * 64 + kk]);
    const float bias = ba[dir * 64 + kk]; float run = 0.f;
#pragma unroll
    for (int gb = 0; gb < 2; ++gb) {
        u32x4 L[8][2];
#pragma unroll
        for (int i = 0; i < 8; ++i) { const LAS u32x4* l4 = (const LAS u32x4*)(lr + (dir * 64 + qtr * 16 + gb * 8 + i) * 8); L[i][0] = l4[0]; L[i][1] = l4[1]; }
        asm volatile("s_waitcnt lgkmcnt(0)" ::: "memory");
#pragma unroll
        for (int i = 0; i < 8; ++i) { const u32x4 v0 = L[i][0], v1 = L[i][1];
            float x = bias, y = 0.f;
            x = dot2bf(v0.x, w2[0], x); y = dot2bf(v0.y, w2[1], y); x = dot2bf(v0.z, w2[2], x); y = dot2bf(v0.w, w2[3], y);
            x = dot2bf(v1.x, w2[4], x); y = dot2bf(v1.y, w2[5], y); x = dot2bf(v1.z, w2[6], x); y = dot2bf(v1.w, w2[7], y);
            x += y;
            const float li = -(fmaxf(-x, 0.f) + 0.6931471805599453f * __builtin_amdgcn_logf(1.0f + __builtin_amdgcn_exp2f(-LOG2E * fabsf(x)))) * (1.0f / 16.0f);
            run += li; c[gb * 8 + i] = run; la[gb * 8 + i] = li; }
    }
    tot[(dir * 4 + qtr) * 64 + kk] = run;
    lds_barrier();
    off = 0.f; all = 0.f;
#pragma unroll
    for (int q = 0; q < 4; ++q) { const float v = tot[(dir * 4 + q) * 64 + kk]; all += v; if (q < qtr) off += v; }
}

__device__ __forceinline__ unsigned gla_touch(const Params& p, int un, bool states) {
    const bf16_t* Z = (const bf16_t*)(p.ws + WS_BIG); const int tid = ltid(); unsigned r = 0u;
    if (GLA_TOUCH && un < NCHUNK * 4) { const int gc = un >> 2, h = un & 3;
        if (tid < 448) { const int t = tid & 63, w = tid >> 6; const int col = w == 0 ? ZQ + h * 64 : w == 1 ? ZK + h * 64 : w == 2 ? ZV + h * 128 : w == 3 ? ZV + h * 128 + 64 : w == 4 ? ZR + h * 128 : w == 5 ? ZR + h * 128 + 64 : ZLF;
            r = *(const unsigned*)(Z + ((size_t)gc * 64 + t) * NZ + col); }
        if (states && tid < 256) r ^= *(const unsigned*)((const bf16_t*)(p.ws + WS_ST) + (size_t)(gc * 4 + h) * 2 * 8192 + tid * 64); }
    return r;
}
__device__ __forceinline__ void gla_g1_unit(const Params& p, LAS unsigned char* lds, int gc, int h, int un) {
    const bf16_t* Z = (const bf16_t*)(p.ws + WS_BIG); bf16_t* ST = (bf16_t*)(p.ws + WS_ST); float* DEC = (float*)(p.ws + WS_DEC);
    const int tid = ltid(), lane = tid & 63, wave = tid >> 6, dir = tid >> 8, qtr = (tid >> 6) & 3, kk = tid & 63; const size_t tok0 = (size_t)gc * 64;
    gla_load(p, Z, lds, gc, h, false);
    const unsigned pfv = gla_touch(p, un, false);
    const LAS bf16_t* kraw = (const LAS bf16_t*)(lds + GL_KR) + (qtr * 16) * 72 + kk;
    float c[16], la[16], off, all; gla_gates(lds, c, la, off, all);
    LAS bf16_t* KeT = (LAS bf16_t*)(lds + GL_A);
#pragma unroll
    for (int i = 0; i < 16; ++i) { const int t = qtr * 16 + i; const float e = __builtin_amdgcn_exp2f(LOG2E * (dir == 0 ? all - (off + c[i]) : off + c[i] - la[i]));
        KeT[(dir * 64 + kk) * 72 + t] = f2bf1(bf2f(kraw[i * 72]) * e); }
    if (qtr == 0) DEC[((size_t)(gc * 4 + h) * 2 + dir) * 64 + kk] = __builtin_amdgcn_exp2f(LOG2E * all);
    lds_barrier();
    { const LAS bf16_t* vT = (const LAS bf16_t*)(lds + GL_VT); const int wd = wave >> 2, wq = wave & 3, fr = lane & 15, quad = lane >> 4;
      bf16_t* dst = ST + ((size_t)(gc * 4 + h) * 2 + wd) * 8192;
#pragma unroll
      for (int dd = 0; dd < 2; ++dd) { const int dvt = 2 * wq + dd; bf16x8 b[2];
#pragma unroll
        for (int ks = 0; ks < 2; ++ks) b[ks] = *(const LAS bf16x8*)(vT + (dvt * 16 + fr) * 72 + ks * 32 + quad * 8);
#pragma unroll
        for (int kp = 0; kp < 2; ++kp) { u32x2 o[2];
#pragma unroll
          for (int kq = 0; kq < 2; ++kq) { const int kt = 2 * kp + kq; f32x4 acc = {0.f, 0.f, 0.f, 0.f};
#pragma unroll
            for (int ks = 0; ks < 2; ++ks) { const bf16x8 a = *(const LAS bf16x8*)(KeT + (wd * 64 + kt * 16 + fr) * 72 + ks * 32 + quad * 8); acc = MFMA16(a, b[ks], acc); }
            o[kq].x = cvt_pk_bf16(acc[0], acc[1]); o[kq].y = cvt_pk_bf16(acc[2], acc[3]); }
          const auto rx = __builtin_amdgcn_permlane16_swap(o[0].x, o[1].x, false, false), ry = __builtin_amdgcn_permlane16_swap(o[0].y, o[1].y, false, false);
          u32x4 w; w.x = rx[0]; w.y = ry[0]; w.z = rx[1]; w.w = ry[1];
          const int ko = (quad & 1) ? (2 * kp + 1) * 16 + (quad - 1) * 4 : (2 * kp) * 16 + quad * 4;
          *(u32x4*)(dst + (dvt * 16 + fr) * 64 + ko) = w; } } }
    ((unsigned*)(p.ws + WS_DUMMY))[blockIdx.x * NTHREADS + tid] = pfv;
    lds_barrier();
}

template <int EL, int NB> __device__ __forceinline__ void g2_scan(bf16_t* ST, const float* DEC, int c0, int n, int h, int dir, int eo) {
    const int k0 = eo & 63;
    float S[EL];
#pragma unroll
    for (int e = 0; e < EL; ++e) S[e] = 0.f;
    for (int i0 = 0; i0 < n; i0 += NB) {
        unsigned kv[NB][EL / 2]; float d[NB][EL];
#pragma unroll
        for (int u = 0; u < NB; ++u) { const int i = i0 + u, c = dir == 0 ? c0 + i : c0 + n - 1 - i; const size_t slot = (size_t)(c * 4 + h) * 2 + dir;
            if constexpr (EL == 8) { const u32x4 t = *(const u32x4*)(ST + slot * 8192 + eo); kv[u][0] = t.x; kv[u][1] = t.y; kv[u][2] = t.z; kv[u][3] = t.w; }
            else { const u32x2 t = *(const u32x2*)(ST + slot * 8192 + eo); kv[u][0] = t.x; kv[u][1] = t.y; }
#pragma unroll
            for (int q = 0; q < EL / 4; ++q) { const f32x4 t = *(const f32x4*)(DEC + slot * 64 + k0 + 4 * q); d[u][4 * q] = t[0]; d[u][4 * q + 1] = t[1]; d[u][4 * q + 2] = t[2]; d[u][4 * q + 3] = t[3]; } }
#pragma unroll
        for (int u = 0; u < NB; ++u) {
            const int i = i0 + u, c = dir == 0 ? c0 + i : c0 + n - 1 - i; const size_t slot = (size_t)(c * 4 + h) * 2 + dir;
            if constexpr (EL == 8) { u32x4 o; o.x = cvt_pk_bf16(S[0], S[1]); o.y = cvt_pk_bf16(S[2], S[3]); o.z = cvt_pk_bf16(S[4], S[5]); o.w = cvt_pk_bf16(S[6], S[7]); *(u32x4*)(ST + slot * 8192 + eo) = o; }
            else { u32x2 o; o.x = cvt_pk_bf16(S[0], S[1]); o.y = cvt_pk_bf16(S[2], S[3]); *(u32x2*)(ST + slot * 8192 + eo) = o; }
#pragma unroll
            for (int e = 0; e < EL / 2; ++e) { S[2 * e] = d[u][2 * e] * S[2 * e] + __uint_as_float(kv[u][e] << 16); S[2 * e + 1] = d[u][2 * e + 1] * S[2 * e + 1] + __uint_as_float(kv[u][e] & 0xffff0000u); }
        }
    }
}
__device__ __forceinline__ void gla_g2(const Params& p) {
    bf16_t* ST = (bf16_t*)(p.ws + WS_ST); const float* DEC = (const float*)(p.ws + WS_DEC);
    const int tid = ltid(), lane = tid & 63, wave = tid >> 6; const int gw = blockIdx.x * 8 + wave, NGW = gridDim.x * 8;
    if (gw < 256) { const int r = gw, h = r >> 6, dir = (r >> 5) & 1, part = r & 31; g2_scan<4, 16>(ST, DEC, 1024, 256, h, dir, part * 256 + lane * 4); }
    else if (NGW > 256) for (int it = gw - 256; it < 4096; it += NGW - 256) { const int c0 = (it >> 7) * 32, r = it & 127, h = r >> 5, dir = (r >> 4) & 1, part = r & 15; g2_scan<8, 8>(ST, DEC, c0, 32, h, dir, part * 512 + lane * 8); }
}

__device__ __forceinline__ void gla_g3_unit(const Params& p, LAS unsigned char* lds, int gc, int h, int un) {
    const bf16_t* Z = (const bf16_t*)(p.ws + WS_BIG); const bf16_t* ST = (const bf16_t*)(p.ws + WS_ST); bf16_t* OC = (bf16_t*)(p.ws + WS_ACTA);
    const int tid = ltid(), lane = tid & 63, wave = tid >> 6, dir = tid >> 8, qtr = (tid >> 6) & 3, kk = tid & 63, fr = lane & 15, quad = lane >> 4; const size_t tok0 = (size_t)gc * 64;
    u32x2 rr[4]; bf16x8 bf_[2], bb[2];
#pragma unroll
    for (int ti = 0; ti < 4; ++ti) rr[ti] = *(const u32x2*)(Z + (tok0 + ti * 16 + fr) * NZ + ZR + h * 128 + wave * 16 + quad * 4);
    { const bf16_t* Sf = ST + ((size_t)(gc * 4 + h) * 2 + 0) * 8192; const bf16_t* Sb = Sf + 8192;
#pragma unroll
      for (int ks = 0; ks < 2; ++ks) { const int o = ks * 32 + quad * 8; bf_[ks] = *(const bf16x8*)(Sf + (wave * 16 + fr) * 64 + o); bb[ks] = *(const bf16x8*)(Sb + (wave * 16 + fr) * 64 + o); } }
    gla_load(p, Z, lds, gc, h, true);
    const unsigned pfv = gla_touch(p, un, true);
    const LAS bf16_t* kraw = (const LAS bf16_t*)(lds + GL_KR) + (qtr * 16) * 72 + kk; const LAS bf16_t* qraw = (const LAS bf16_t*)(lds + GL_QR) + (qtr * 16) * 72 + kk;
    float c[16], la[16], off, all; gla_gates(lds, c, la, off, all);
    LAS bf16_t* QK = (LAS bf16_t*)(lds + GL_A);
    { LAS bf16_t* Qd = QK + (dir * 2) * 64 * 72; LAS bf16_t* Kd = Qd + 64 * 72;
#pragma unroll
      for (int i = 0; i < 16; ++i) { const int t = qtr * 16 + i; const float b = dir == 0 ? off + c[i] : all - (off + c[i]) + la[i];
        const float b2 = LOG2E * b; Qd[t * 72 + kk] = f2bf1(bf2f(qraw[i * 72]) * __builtin_amdgcn_exp2f(b2)); Kd[t * 72 + kk] = f2bf1(bf2f(kraw[i * 72]) * __builtin_amdgcn_exp2f(-b2)); } }
    lds_barrier();
    const LAS bf16_t* Qf = QK; const LAS bf16_t* Kf = QK + 64 * 72; const LAS bf16_t* Qb = QK + 2 * 64 * 72; const LAS bf16_t* Kb = QK + 3 * 64 * 72;
    LAS bf16_t* P = (LAS bf16_t*)(lds + GL_P); const LAS bf16_t* vT = (const LAS bf16_t*)(lds + GL_VT);
#pragma unroll
    for (int pp = 0; pp < 2; ++pp) { const int pt = 2 * wave + pp, ti = pt >> 2, tj = pt & 3; f32x4 af = {0.f, 0.f, 0.f, 0.f}, ab = {0.f, 0.f, 0.f, 0.f};
#pragma unroll
        for (int ks = 0; ks < 2; ++ks) { const int o = ks * 32 + quad * 8;
            af = MFMA16(*(const LAS bf16x8*)(Kf + (tj * 16 + fr) * 72 + o), *(const LAS bf16x8*)(Qf + (ti * 16 + fr) * 72 + o), af);
            ab = MFMA16(*(const LAS bf16x8*)(Kb + (tj * 16 + fr) * 72 + o), *(const LAS bf16x8*)(Qb + (ti * 16 + fr) * 72 + o), ab); }
        float pv[4];
#pragma unroll
        for (int j = 0; j < 4; ++j) { const int s = tj * 16 + quad * 4 + j, t = ti * 16 + fr; pv[j] = (s <= t ? af[j] : 0.f) + (s >= t ? ab[j] : 0.f); }
        u32x2 o; o.x = cvt_pk_bf16(pv[0], pv[1]); o.y = cvt_pk_bf16(pv[2], pv[3]);
        *(LAS u32x2*)(P + (ti * 16 + fr) * 72 + tj * 16 + quad * 4) = o; }
    ((unsigned*)(p.ws + WS_DUMMY))[blockIdx.x * NTHREADS + tid] = pfv;
    lds_barrier();
    f32x4 acc[4];
    { bf16x8 av[2];
#pragma unroll
      for (int ks = 0; ks < 2; ++ks) av[ks] = *(const LAS bf16x8*)(vT + (wave * 16 + fr) * 72 + ks * 32 + quad * 8);
#pragma unroll
      for (int ti = 0; ti < 4; ++ti) { f32x4 a = {0.f, 0.f, 0.f, 0.f};
#pragma unroll
          for (int ks = 0; ks < 2; ++ks) { const int o = ks * 32 + quad * 8;
              a = MFMA16(av[ks], *(const LAS bf16x8*)(P + (ti * 16 + fr) * 72 + o), a);
              a = MFMA16(bf_[ks], *(const LAS bf16x8*)(Qf + (ti * 16 + fr) * 72 + o), a);
              a = MFMA16(bb[ks], *(const LAS bf16x8*)(Qb + (ti * 16 + fr) * 72 + o), a); }
          acc[ti] = a; } }
    LAS float* ssw = (LAS float*)(lds + GL_SS);
#pragma unroll
    for (int ti = 0; ti < 4; ++ti) { float s = (acc[ti][0] * acc[ti][0] + acc[ti][1] * acc[ti][1]) + (acc[ti][2] * acc[ti][2] + acc[ti][3] * acc[ti][3]);
        s = quad_sum(s); if (quad == 0) ssw[wave * 64 + ti * 16 + fr] = s; }
    lds_barrier();
    { const int dv0 = h * 128 + wave * 16 + quad * 4; const f32x4 g = *(const f32x4*)(p.in[12] + dv0);
      u32x2 oo[4];
#pragma unroll
      for (int ti = 0; ti < 4; ++ti) { const int t = ti * 16 + fr; float tot = 0.f;
#pragma unroll
          for (int w8 = 0; w8 < 8; ++w8) tot += ssw[w8 * 64 + t];
          const float rinv = rsqrtf(tot * (1.0f / 128.0f) + EPS);
          const float r0 = __uint_as_float(rr[ti].x << 16), r1 = __uint_as_float(rr[ti].x & 0xffff0000u), r2 = __uint_as_float(rr[ti].y << 16), r3 = __uint_as_float(rr[ti].y & 0xffff0000u);
#define SILU_(r_) ((r_) * __builtin_amdgcn_rcpf(1.0f + __builtin_amdgcn_exp2f(-LOG2E * (r_))))
          oo[ti].x = cvt_pk_bf16(acc[ti][0] * rinv * g[0] * SILU_(r0), acc[ti][1] * rinv * g[1] * SILU_(r1));
          oo[ti].y = cvt_pk_bf16(acc[ti][2] * rinv * g[2] * SILU_(r2), acc[ti][3] * rinv * g[3] * SILU_(r3));
#undef SILU_
      }
#pragma unroll
      for (int tp = 0; tp < 2; ++tp) {
          const auto rx = __builtin_amdgcn_permlane16_swap(oo[2 * tp].x, oo[2 * tp + 1].x, false, false), ry = __builtin_amdgcn_permlane16_swap(oo[2 * tp].y, oo[2 * tp + 1].y, false, false);
          u32x4 w; w.x = rx[0]; w.y = ry[0]; w.z = rx[1]; w.w = ry[1];
          const int t = ((quad & 1) ? 2 * tp + 1 : 2 * tp) * 16 + fr, dvs = (quad & 1) ? dv0 - 4 : dv0;
          *(u32x4*)(OC + (tok0 + t) * DM + dvs) = w; } }
    lds_barrier();
}
constexpr int AT_TILE = 512, AT_O = 0  , AT_M = AT_TILE * 68 * 4, AT_L = AT_M + AT_TILE * 4;
__device__ __forceinline__ void attn_group(int br, int g, int p0, int& cls, int& qi) {
    if (br == 0) { cls = 0; qi = p0 + 32 * g; } else if (br == 1) { cls = g >> 2; qi = (p0 >> 2) + 32 * (g & 3); } else { cls = g; qi = p0 >> 4; }
}
__device__ __forceinline__ void attn_load(const bf16_t* Zh, int s0, int sh, int n, int cls, int kb, int lane, bf16x8 (&k)[4], bf16x8 (&v)[4]) {
    const int fr = lane & 15, quad = lane >> 4;
    if (kb >= 0 && kb + 32 <= n) {
        const unsigned o0 = (unsigned)(s0 + ((kb + fr) << sh) + cls) * (unsigned)NZ + quad * 8, o1 = o0 + ((unsigned)(16 << sh)) * (unsigned)NZ;
        k[0] = *(const bf16x8*)(Zh + o0 + ZAK); k[1] = *(const bf16x8*)(Zh + o0 + ZAK + 32); v[0] = *(const bf16x8*)(Zh + o0 + ZAV); v[1] = *(const bf16x8*)(Zh + o0 + ZAV + 32);
        k[2] = *(const bf16x8*)(Zh + o1 + ZAK); k[3] = *(const bf16x8*)(Zh + o1 + ZAK + 32); v[2] = *(const bf16x8*)(Zh + o1 + ZAV); v[3] = *(const bf16x8*)(Zh + o1 + ZAV + 32);
    } else {
#pragma unroll
        for (int kt = 0; kt < 2; ++kt) { int ki = kb + kt * 16 + fr; ki = ki < 0 ? 0 : (ki >= n ? n - 1 : ki);
            const bf16_t* r = Zh + (unsigned)(s0 + (ki << sh) + cls) * (unsigned)NZ + quad * 8;
            k[kt * 2] = *(const bf16x8*)(r + ZAK); k[kt * 2 + 1] = *(const bf16x8*)(r + ZAK + 32); v[kt * 2] = *(const bf16x8*)(r + ZAV); v[kt * 2 + 1] = *(const bf16x8*)(r + ZAV + 32); }
    }
}
__device__ __forceinline__ void attn_unit(const Params& p, LAS unsigned char* lds, int tile, int h, int variant) {
    const bf16_t* Zh = (const bf16_t*)(p.ws + WS_BIG) + h * 64; bf16_t* OC = (bf16_t*)(p.ws + WS_ACTA);
    const int tid = ltid(), lane = tid & 63, wave = tid >> 6, fr = lane & 15, quad = lane >> 4;
    const int T0 = tile * AT_TILE, s0 = T0 < MPROMPT ? (T0 & ~2047) : MPROMPT, L = T0 < MPROMPT ? 2048 : 16384, p0 = T0 - s0;
    LAS float* Ol = (LAS float*)(lds + AT_O); LAS float* ml = (LAS float*)(lds + AT_M); LAS float* ll = (LAS float*)(lds + AT_L);
    const float slope2 = exp2f(-(float)(h + 1)) * LOG2E;
    unsigned pfv = 0u;
    { int lo = T0 - 1024; lo = lo < s0 ? s0 : lo; int hi = T0 + AT_TILE + 1024; hi = hi > s0 + L ? s0 + L : hi; const int cnt = 2 * (hi - lo);
#pragma unroll
      for (int j = 0; j < ATT_TOUCH; ++j) { const int i = tid + 512 * j; if (i < cnt) pfv ^= *(const unsigned*)(Zh + (size_t)(lo + (i >> 1)) * NZ + ((i & 1) ? ZAV : ZAK)); }
      pfv ^= *(const unsigned*)(Zh + (size_t)(T0 + tid) * NZ + ZAQ); }
    bf16x8 isel[2];
#pragma unroll
    for (int hf = 0; hf < 2; ++hf)
#pragma unroll
        for (int jj = 0; jj < 8; ++jj) isel[hf][jj] = (quad * 8 + jj == hf * 16 + fr) ? (short)0x3F80 : (short)0;
#pragma unroll 1
    for (int br = 0; br < 3; ++br) {
        const int sh = 2 * br, n = L >> sh; const float nbc = -slope2 * (float)(1 << sh);
        bf16x8 kf[4], vf[4];
        { int cls, qi; attn_group(br, 2 * wave, p0, cls, qi); attn_load(Zh, s0, sh, n, cls, qi - 64, lane, kf, vf); }
        bf16x8 qf[2][2]; float m[2], l[2]; f32x4 O[2][4]; int tq[2], tl[2];
#pragma unroll
        for (int nt = 0; nt < 2; ++nt) { m[nt] = -1e30f; l[nt] = 0.f; tq[nt] = 0; tl[nt] = 0; qf[nt][0] = kf[0]; qf[nt][1] = kf[0];
#pragma unroll
            for (int dt = 0; dt < 4; ++dt) O[nt][dt] = (f32x4){0.f, 0.f, 0.f, 0.f}; }
#pragma unroll 1
        for (int it = 0; it < 10; ++it) {
            const int gg = it >= 5 ? 1 : 0, ch = it - 5 * gg;
            int cls, qi; attn_group(br, 2 * wave + gg, p0, cls, qi);
            if (ch == 0) {
#pragma unroll
                for (int nt = 0; nt < 2; ++nt) {
                    tq[nt] = s0 + ((qi + 16 * nt + fr) << sh) + cls; tl[nt] = tq[nt] - T0;
#pragma unroll
                    for (int ks = 0; ks < 2; ++ks) qf[nt][ks] = *(const bf16x8*)(Zh + (unsigned)tq[nt] * (unsigned)NZ + ZAQ + ks * 32 + quad * 8);
                    if (br == 0) { m[nt] = -1e30f; l[nt] = 0.f;
#pragma unroll
                        for (int dt = 0; dt < 4; ++dt) O[nt][dt] = (f32x4){0.f, 0.f, 0.f, 0.f};
                    } else { m[nt] = ml[tl[nt]]; l[nt] = quad == 0 ? ll[tl[nt]] : 0.f;
#pragma unroll
                        for (int dt = 0; dt < 4; ++dt) O[nt][dt] = *(const LAS f32x4*)(Ol + tl[nt] * 68 + dt * 16 + quad * 4); }
                }
            }
            const int kb = qi - 64 + 32 * ch;
            f32x4 S[2][2], vt[2][4];
#pragma unroll
            for (int nt = 0; nt < 2; ++nt)
#pragma unroll
                for (int kt = 0; kt < 2; ++kt) { f32x4 a = {0.f, 0.f, 0.f, 0.f}; a = MFMA16(kf[kt * 2], qf[nt][0], a); a = MFMA16(kf[kt * 2 + 1], qf[nt][1], a); S[nt][kt] = a; }
#pragma unroll
            for (int kt = 0; kt < 2; ++kt)
#pragma unroll
                for (int dt = 0; dt < 4; ++dt) vt[kt][dt] = MFMA16(vf[kt * 2 + (dt >> 1)], isel[dt & 1], ((f32x4){0.f, 0.f, 0.f, 0.f}));
            if (it < 9 && variant != 1) { const int g2 = it + 1 >= 5 ? 1 : 0, ch2 = it + 1 - 5 * g2; int cls2, qi2; attn_group(br, 2 * wave + g2, p0, cls2, qi2);
                attn_load(Zh, s0, sh, n, cls2, qi2 - 64 + 32 * ch2, lane, kf, vf); }
            bf16x8 vtp[4];
#pragma unroll
            for (int dt = 0; dt < 4; ++dt) { u32x4 vw; vw.x = cvt_pk_bf16(vt[0][dt][0], vt[0][dt][1]); vw.y = cvt_pk_bf16(vt[0][dt][2], vt[0][dt][3]); vw.z = cvt_pk_bf16(vt[1][dt][0], vt[1][dt][1]); vw.w = cvt_pk_bf16(vt[1][dt][2], vt[1][dt][3]);
                vtp[dt] = __builtin_bit_cast(bf16x8, vw); }
            const bool seqedge = (kb < 0 || kb + 32 > n);
#pragma unroll
            for (int nt = 0; nt < 2; ++nt) {
                float sv[8]; float mx = -1e30f;
                const int relb = -64 + 32 * ch + quad * 4 - fr - 16 * nt;
                if (seqedge) {
#pragma unroll
                    for (int kt = 0; kt < 2; ++kt)
#pragma unroll
                        for (int j = 0; j < 4; ++j) { const int rel = relb + kt * 16 + j, key = qi + 16 * nt + fr + rel, ar = rel < 0 ? -rel : rel;
                            const bool ok = (ar <= 64) && ((unsigned)key < (unsigned)n); const float s = ok ? fmaf(nbc, (float)ar, S[nt][kt][j]) : -3.0e38f; sv[kt * 4 + j] = s; mx = fmaxf(mx, s); }
                } else { const float frel = (float)relb; const int dl = fr + 16 * nt - quad * 4;
                    if (ch == 0) {
#pragma unroll
                        for (int kt = 0; kt < 2; ++kt)
#pragma unroll
                            for (int j = 0; j < 4; ++j) { float s = fmaf(nbc, fabsf(frel + (float)(kt * 16 + j)), S[nt][kt][j]); s = (kt * 16 + j >= dl) ? s : -3.0e38f; sv[kt * 4 + j] = s; mx = fmaxf(mx, s); }
                    } else if (ch == 4) {
#pragma unroll
                        for (int kt = 0; kt < 2; ++kt)
#pragma unroll
                            for (int j = 0; j < 4; ++j) { float s = fmaf(nbc, fabsf(frel + (float)(kt * 16 + j)), S[nt][kt][j]); s = (kt * 16 + j <= dl) ? s : -3.0e38f; sv[kt * 4 + j] = s; mx = fmaxf(mx, s); }
                    } else {
#pragma unroll
                        for (int kt = 0; kt < 2; ++kt)
#pragma unroll
                            for (int j = 0; j < 4; ++j) { const float s = fmaf(nbc, fabsf(frel + (float)(kt * 16 + j)), S[nt][kt][j]); sv[kt * 4 + j] = s; mx = fmaxf(mx, s); }
                    }
                }
                if (!__all(mx - m[nt] <= 8.0f)) {
                    mx = quad_max(mx);
                    const float mn = fmaxf(m[nt], mx), alpha = __builtin_amdgcn_exp2f(m[nt] - mn);
                    l[nt] *= alpha; m[nt] = mn;
#pragma unroll
                    for (int dt = 0; dt < 4; ++dt) O[nt][dt] = O[nt][dt] * alpha;
                }
                float ps = 0.f; float pv[8]; const float mcur = m[nt];
#pragma unroll
                for (int e = 0; e < 8; ++e) { pv[e] = __builtin_amdgcn_exp2f(sv[e] - mcur); ps += pv[e]; }
                l[nt] += ps;
                u32x4 pw; pw.x = cvt_pk_bf16(pv[0], pv[1]); pw.y = cvt_pk_bf16(pv[2], pv[3]); pw.z = cvt_pk_bf16(pv[4], pv[5]); pw.w = cvt_pk_bf16(pv[6], pv[7]);
                const bf16x8 pf = __builtin_bit_cast(bf16x8, pw);
#pragma unroll
                for (int dt = 0; dt < 4; ++dt) O[nt][dt] = MFMA16(vtp[dt], pf, O[nt][dt]);
            }
            if (ch == 4) {
#pragma unroll
                for (int nt = 0; nt < 2; ++nt) {
                    const float lt = quad_sum(l[nt]);
                    if (br < 2) { if (quad == 0) { ml[tl[nt]] = m[nt]; ll[tl[nt]] = lt; }
#pragma unroll
                        for (int dt = 0; dt < 4; ++dt) *(LAS f32x4*)(Ol + tl[nt] * 68 + dt * 16 + quad * 4) = O[nt][dt];
                    } else { const float inv = 1.0f / lt; u32x2 oo[4];
#pragma unroll
                        for (int dt = 0; dt < 4; ++dt) { oo[dt].x = cvt_pk_bf16(O[nt][dt][0] * inv, O[nt][dt][1] * inv); oo[dt].y = cvt_pk_bf16(O[nt][dt][2] * inv, O[nt][dt][3] * inv); }
#pragma unroll
                        for (int dp = 0; dp < 2; ++dp) {
                            const auto rx = __builtin_amdgcn_permlane16_swap(oo[2 * dp].x, oo[2 * dp + 1].x, false, false), ry = __builtin_amdgcn_permlane16_swap(oo[2 * dp].y, oo[2 * dp + 1].y, false, false);
                            u32x4 w; w.x = rx[0]; w.y = ry[0]; w.z = rx[1]; w.w = ry[1];
                            const int col = (quad & 1) ? (2 * dp + 1) * 16 + (quad - 1) * 4 : (2 * dp) * 16 + quad * 4;
                            *(u32x4*)(OC + (size_t)tq[nt] * DM + 512 + h * 64 + col) = w; } }
                }
            }
        }
        lds_barrier();
    }
    ((unsigned*)(p.ws + WS_DUMMY))[blockIdx.x * NTHREADS + tid] = pfv;
}
__global__ void __launch_bounds__(NTHREADS, 2) hymba_fwd(Params p) {
    extern __shared__ __attribute__((aligned(16))) unsigned char smem[];
    LAS unsigned char* lds = (LAS unsigned char*)smem;
    cg::grid_group grid = cg::this_grid();
    volatile LAS unsigned* bst = (volatile LAS unsigned*)(lds + LDS_BYTES - 64);
    if (threadIdx.x < 2) bst[threadIdx.x] = 0u;
    __syncthreads();
    const XcdBarrier xbar = xcd_barrier_post((unsigned*)(p.ws + WS_BAR), bst);
    unsigned char* ws = p.ws;
    float* ssq = (float*)(ws + WS_SSQ);
    bf16_t* actA = (bf16_t*)(ws + WS_ACTA); bf16_t* big = (bf16_t*)(ws + WS_BIG);
    bf16_t* hb0 = (bf16_t*)p.out; bf16_t* hb1 = hb0 + (size_t)MTOK * DM;
    pg8::StaticOrder S;
    for (int rep = 0; rep < PROBE_PRO; ++rep) prologue(p, lds);
    grid.sync();
    { pg8::Gemm g{actA, (const bf16_t*)(ws + WS_W1GU), MTOK, NGU, DM}; S.init(MTOK, NGU, gridDim.x, blockIdx.x); EpiSwiglu E{big, ssq};
      pg8::gemm_phase<EpiSwiglu, pg8::StaticOrder, true, true>(lds, g, S, E);
      if (PROBE_P1 == 2) { xcd_barrier(xbar); pg8::gemm_phase<EpiSwiglu, pg8::StaticOrder, true, true>(lds, g, S, E); }
      { const int nwg = (MTOK / 256) * (NGU / 256), G = (int)gridDim.x, rem = nwg % G, c = (int)blockIdx.x; const int tid = ltid();
        if (c >= rem) deferred_weights(p, lds, (c - rem) * 8 + (tid >> 6), (G - rem) * 8); } }
    xcd_barrier(xbar);
    { pg8::Gemm g{big, (const bf16_t*)(ws + WS_W1D), MTOK, DM, DFF}; S.init(MTOK, DM, gridDim.x, blockIdx.x); EpiResid<true> E{nullptr, nullptr, 0, actA, hb0, ssq + MTOK, 0.5f};
      pg8::gemm_phase<EpiResid<true>, pg8::StaticOrder, true, true>(lds, g, S, E); }
    xcd_barrier(xbar);
    { pg8::Gemm g{hb0, (const bf16_t*)(ws + WS_WIN), MTOK, 3072, DM}; S.init(MTOK, 3072, gridDim.x, blockIdx.x); EpiZ E{big, ssq + MTOK};
      pg8::gemm_phase<EpiZ, pg8::StaticOrder, true, true>(lds, g, S, E); }
    for (int it = blockIdx.x; it < MTOK / 64; it += gridDim.x) lr_gemm_item(hb0, (const bf16_t*)(ws + WS_WIN) + (size_t)3072 * DM, ssq + MTOK, big, lds, it);
    xcd_barrier(xbar);
    for (int u = blockIdx.x; u < 160 * 8 * PROBE_ATT; u += gridDim.x) attn_unit(p, lds, (u % 1280) >> 3, u & 7, (PROBE_ATT == 2 && u < 1280) ? PROBE_VAR : 0);
    for (int u = blockIdx.x; u < NCHUNK * 4 * PROBE_G1; u += gridDim.x) gla_g1_unit(p, lds, (u % (NCHUNK * 4)) >> 2, u & 3, u + gridDim.x);
    xcd_barrier(xbar);
    gla_g2(p);
    xcd_barrier(xbar);
    for (int u = blockIdx.x; u < NCHUNK * 4 * PROBE_G3; u += gridDim.x) gla_g3_unit(p, lds, (u % (NCHUNK * 4)) >> 2, u & 3, u + gridDim.x);
    xcd_barrier(xbar);
    { pg8::Gemm g{actA, (const bf16_t*)(ws + WS_WOUT), MTOK, DM, DM}; S.init(MTOK, DM, gridDim.x, blockIdx.x); EpiResid<true> E{nullptr, nullptr, 0, hb0, hb1, ssq + 2 * MTOK, 1.0f};
      pg8::gemm_phase<EpiResid<true>, pg8::StaticOrder, true, true>(lds, g, S, E); }
    xcd_barrier(xbar);
    { pg8::Gemm g{hb1, (const bf16_t*)(ws + WS_W2GU), MTOK, NGU, DM}; S.init(MTOK, NGU, gridDim.x, blockIdx.x); EpiSwiglu E{big, ssq + 2 * MTOK};
      pg8::gemm_phase<EpiSwiglu, pg8::StaticOrder, true, true>(lds, g, S, E); }
    xcd_barrier(xbar);
    { pg8::Gemm g{big, (const bf16_t*)(ws + WS_W2D), MTOK, DM, DFF}; S.init(MTOK, DM, gridDim.x, blockIdx.x); EpiResid<true> E{nullptr, nullptr, 0, hb1, actA, ssq + 3 * MTOK, 0.5f};
      pg8::gemm_phase<EpiResid<true>, pg8::StaticOrder, true, true>(lds, g, S, E); }
    xcd_barrier(xbar);
    { const int tid = ltid(), lane = tid & 63, wave = tid >> 6; const int gw = blockIdx.x * 8 + wave, NGW = gridDim.x * 8; const float* gf = p.in[18];
      f32x4 gv[4];
#pragma unroll
      for (int j = 0; j < 4; ++j) gv[j] = ((const f32x4*)gf)[2 * lane + (j & 1) + 128 * (j >> 1)];
      for (int row = gw; row < MTOK; row += 2 * NGW) {
          const int row2 = row + NGW < MTOK ? row + NGW : row;
          const u32x4 a0 = ((const u32x4*)(actA + (size_t)row * DM))[lane], a1 = ((const u32x4*)(actA + (size_t)row * DM))[lane + 64];
          const u32x4 b0 = ((const u32x4*)(actA + (size_t)row2 * DM))[lane], b1 = ((const u32x4*)(actA + (size_t)row2 * DM))[lane + 64];
          const float rs = rsqrtf(ssq[3 * MTOK + row] * (1.0f / DM) + EPS), rs2 = rsqrtf(ssq[3 * MTOK + row2] * (1.0f / DM) + EPS);
#define P10_OUT(rw, scale, q0, q1) do { f32x4* o = (f32x4*)(p.out + (size_t)(rw) * DM); \
          o[2 * lane] = (f32x4){__uint_as_float(q0.x << 16), __uint_as_float(q0.x & 0xffff0000u), __uint_as_float(q0.y << 16), __uint_as_float(q0.y & 0xffff0000u)} * (scale) * gv[0]; \
          o[2 * lane + 1] = (f32x4){__uint_as_float(q0.z << 16), __uint_as_float(q0.z & 0xffff0000u), __uint_as_float(q0.w << 16), __uint_as_float(q0.w & 0xffff0000u)} * (scale) * gv[1]; \
          o[128 + 2 * lane] = (f32x4){__uint_as_float(q1.x << 16), __uint_as_float(q1.x & 0xffff0000u), __uint_as_float(q1.y << 16), __uint_as_float(q1.y & 0xffff0000u)} * (scale) * gv[2]; \
          o[128 + 2 * lane + 1] = (f32x4){__uint_as_float(q1.z << 16), __uint_as_float(q1.z & 0xffff0000u), __uint_as_float(q1.w << 16), __uint_as_float(q1.w & 0xffff0000u)} * (scale) * gv[3]; } while (0)
          P10_OUT(row, rs, a0, a1);
          if (row2 != row) P10_OUT(row2, rs2, b0, b1);
#undef P10_OUT
      } }
}

extern "C" void kernel_launch(void* const* d_in, const int* in_sizes, int n_in, void* d_out, int out_size, void* d_ws, size_t ws_size, hipStream_t stream) {
    static int grid = 0;
    if (grid == 0) {
        if (n_in != 19 || out_size != MTOK * DM || ws_size < WS_END) { fprintf(stderr, "kernel_launch: unexpected shapes (n_in %d out %d ws %zu)\n", n_in, out_size, ws_size); grid = -1; return; }
        int dev = 0, cus = 0, per_cu = 0;
        hipGetDevice(&dev); hipDeviceGetAttribute(&cus, hipDeviceAttributeMultiprocessorCount, dev);
        if (hipFuncSetAttribute((const void*)hymba_fwd, hipFuncAttributeMaxDynamicSharedMemorySize, LDS_BYTES) != hipSuccess) { fprintf(stderr, "kernel_launch: hipFuncSetAttribute failed\n"); grid = -1; return; }
        if (hipOccupancyMaxActiveBlocksPerMultiprocessor(&per_cu, (const void*)hymba_fwd, NTHREADS, LDS_BYTES) != hipSuccess || per_cu < 1) { fprintf(stderr, "kernel_launch: occupancy query gave %d\n", per_cu); per_cu = 1; }
        (void)hipGetLastError();
        grid = cus * 1;
    }
    if (grid < 0) return;
    if (hipMemsetAsync((char*)d_ws + WS_BAR, 0, XCD_BAR_WORDS * 4, stream) != hipSuccess) { fprintf(stderr, "kernel_launch: memset of the barrier words failed\n"); return; }
    Params p{};
    for (int i = 0; i < 19; ++i) p.in[i] = (const float*)d_in[i];
    p.out = (float*)d_out; p.ws = (unsigned char*)d_ws;
    void* args[] = {&p};
    hipError_t e = hipLaunchCooperativeKernel((const void*)hymba_fwd, dim3(grid), dim3(NTHREADS), args, LDS_BYTES, stream);
    if (e != hipSuccess) fprintf(stderr, "cooperative launch failed: %s (grid %d)\n", hipGetErrorString(e), grid);
}
```

```cpp
#include <hip/hip_runtime.h>
#include <hip/hip_cooperative_groups.h>
#include <cstdio>
#include <cstdint>
namespace cg = cooperative_groups;
#define PROBE_ATT 1
#define PROBE_G1 1
#define PROBE_G3 1
#define PROBE_PRO 1
#define PROBE_VAR 1
#define PROBE_P1 1
#define ATT_TOUCH 0
#define GLA_TOUCH 0
namespace pg8 {
#define PG8_LAS __attribute__((address_space(3)))
typedef unsigned short bf16_t;
typedef short bf16x8 __attribute__((ext_vector_type(8)));
typedef float f32x4 __attribute__((ext_vector_type(4)));
typedef unsigned u32x4 __attribute__((ext_vector_type(4)));
constexpr int BM = 256, BK = 64, HALF = 128, HTB = HALF * BK * 2  , STAGE_BYTES = 8 * HTB, NXCD = 8, WGM = 8;

__host__ __device__ __forceinline__ int lds_byte(int r, int c) { const int st = (r >> 4) * 2 + (c >> 5), rr = r & 15, cc = c & 31, ob = rr * 64 + cc * 2; return st * 1024 + (ob ^ (((ob >> 9) & 1) << 5)); }
__host__ __device__ __forceinline__ void stage_rc(int b, int& R, int& C) { const int st = b / 1024, sb = b % 1024, swz = sb ^ (((sb >> 9) & 1) << 5); R = (st >> 1) * 16 + swz / 64; C = (st & 1) * 32 + (swz % 64) / 2; }
__host__ __device__ __forceinline__ int perm32(int rho) { const int n = rho >> 4, i = rho & 15; return 8 * (i >> 2) + 4 * n + (i & 3); }

struct Unit { int pm, pn; };
struct Gemm { const bf16_t* A; const bf16_t* Bt; int M, N, K; };

struct StaticOrder {
    int nM, nN, nwg, G, c;
    __host__ __device__ void init(int M, int N, int G_, int c_) { nM = M / BM; nN = N / BM; nwg = nM * nN; G = G_; c = c_; }
    __host__ __device__ bool next(int i, Unit& u) const {
        const long L = (long)i * G + c; if (L >= nwg) return false;
        int wgid = (int)L; { const int q = nwg / NXCD, r = nwg % NXCD, xcd = wgid % NXCD, off = wgid / NXCD; wgid = (xcd < r ? xcd * (q + 1) : r * (q + 1) + (xcd - r) * q) + off; }
        const int nig = WGM * nN, gid = wgid / nig, fm = gid * WGM, gsz = (nM - fm) < WGM ? (nM - fm) : WGM;
        u.pm = fm + ((wgid % nig) % gsz); u.pn = (wgid % nig) / gsz; return true;
    }
    __device__ __forceinline__ void a_ready(const Unit&) const {}
    __device__ __forceinline__ void done(const Unit&) const {}
};
typedef __bf16 bf16x2_hw __attribute__((ext_vector_type(2)));
__device__ __forceinline__ unsigned cvt_pk_bf16(float lo, float hi) { bf16x2_hw v; v[0] = (__bf16)lo; v[1] = (__bf16)hi; return __builtin_bit_cast(unsigned, v); }
template <class Epi, class Sched, bool ALIGN_EPI = false, bool SP2 = false>
__device__ __forceinline__ void gemm_phase(PG8_LAS unsigned char* lds, const Gemm g, const Sched& S, const Epi& E) {
    const int tid = threadIdx.x, wid = __builtin_amdgcn_readfirstlane(tid >> 6), lane = tid & 63, wr = wid >> 2, wc = wid & 3, fr = lane & 15, fq = lane >> 4;
    const int K = g.K, nt = K / BK;
    unsigned voffA[2], voffB[2];
#pragma unroll
    for (int i = 0; i < 2; ++i) { int R, C; stage_rc(tid * 16 + i * 8192, R, C); const int Rb = Epi::PERM ? ((R & ~31) + perm32(R & 31)) : R;
        voffA[i] = (unsigned)(R * K + C) * 2u; voffB[i] = (unsigned)(Rb * K + C) * 2u; }
    const size_t kstep = (size_t)(BK * 2);
    const size_t hstep = (size_t)HALF * K * 2;
    const size_t tstep = 2 * hstep;
    const unsigned ldsw = (unsigned)wid * 1024u;
    const int aoff = lds_byte(wr * 64 + fr, fq * 8), boff = lds_byte(wc * 32 + fr, fq * 8);
#define PG8_SA(b, h) (((b) * 2 + (h)) * HTB)
#define PG8_SB(b, h) ((4 + (b) * 2 + (h)) * HTB)
#define PG8_STAGE(bufoff, gbase, voff) do { _Pragma("unroll") for (int _i = 0; _i < 2; ++_i) \
        __builtin_amdgcn_global_load_lds((const unsigned*)((const char*)(gbase) + (voff)[_i]), (PG8_LAS unsigned*)(lds + (bufoff) + ldsw + _i * 8192), 16, 0, 0); } while (0)
#define PG8_LDA(dst, b, h) do { _Pragma("unroll") for (int m = 0; m < 4; ++m) _Pragma("unroll") for (int k = 0; k < 2; ++k) dst[m][k] = *(const PG8_LAS bf16x8*)(lds + PG8_SA(b, h) + aoff + m * 2048 + k * 1024); } while (0)
#define PG8_LDB(dst, b, h) do { _Pragma("unroll") for (int n = 0; n < 2; ++n) _Pragma("unroll") for (int k = 0; k < 2; ++k) dst[n][k] = *(const PG8_LAS bf16x8*)(lds + PG8_SB(b, h) + boff + n * 2048 + k * 1024); } while (0)
#define PG8_MMA(ai, bj, At, Bt) do { __builtin_amdgcn_s_setprio(1); _Pragma("unroll") for (int m = 0; m < 4; ++m) _Pragma("unroll") for (int n = 0; n < 2; ++n) _Pragma("unroll") for (int k = 0; k < 2; ++k) \
        acc[ai][bj][m][n] = __builtin_amdgcn_mfma_f32_16x16x32_bf16(Bt[n][k], At[m][k], acc[ai][bj][m][n], 0, 0, 0); __builtin_amdgcn_s_setprio(0); } while (0)
#define PG8_WAIT_V(n) asm volatile("s_waitcnt vmcnt(" #n ")" ::: "memory")
#define PG8_WAIT_L(n) asm volatile("s_waitcnt lgkmcnt(" #n ")" ::: "memory")
#define PG8_BAR __builtin_amdgcn_s_barrier()
#define PG8_SCHED __builtin_amdgcn_sched_barrier(0)
    Unit cur, nxt; int ui = 0;
    if (!S.next(0, cur)) return;
    f32x4 acc[2][2][4][2];
#pragma unroll
    for (int a = 0; a < 2; ++a)
#pragma unroll
        for (int b = 0; b < 2; ++b)
#pragma unroll
            for (int m = 0; m < 4; ++m)
#pragma unroll
                for (int n = 0; n < 2; ++n) acc[a][b][m][n] = (f32x4){0.f, 0.f, 0.f, 0.f};
    bf16x8 At[4][2], B0[2][2], B1[2][2];
    const char* cA = (const char*)g.A + (size_t)cur.pm * tstep; const char* cB = (const char*)g.Bt + (size_t)cur.pn * tstep;
    S.a_ready(cur);
    if constexpr (SP2) {
        PG8_STAGE(PG8_SB(0, 0), cB, voffB); PG8_STAGE(PG8_SB(0, 1), cB + hstep, voffB); PG8_STAGE(PG8_SA(0, 0), cA, voffA); PG8_STAGE(PG8_SA(0, 1), cA + hstep, voffA);
        if (wr == 1) PG8_BAR;
        PG8_WAIT_V(2); PG8_BAR;
        PG8_STAGE(PG8_SB(1, 0), cB + kstep, voffB); PG8_STAGE(PG8_SA(1, 0), cA + kstep, voffA); PG8_STAGE(PG8_SB(1, 1), cB + hstep + kstep, voffB);
        PG8_WAIT_V(6); PG8_BAR;
    } else {
        PG8_STAGE(PG8_SB(0, 0), cB, voffB); PG8_STAGE(PG8_SA(0, 0), cA, voffA); PG8_STAGE(PG8_SB(0, 1), cB + hstep, voffB); PG8_STAGE(PG8_SA(0, 1), cA + hstep, voffA);
        if (wr == 1) PG8_BAR;
        PG8_WAIT_V(4); PG8_BAR;
        PG8_STAGE(PG8_SB(1, 0), cB + kstep, voffB); PG8_STAGE(PG8_SA(1, 0), cA + kstep, voffA); PG8_STAGE(PG8_SB(1, 1), cB + hstep + kstep, voffB);
        PG8_WAIT_V(6); PG8_BAR;
    }
    for (;;) {
        const bool has_next = S.next(ui + 1, nxt);
        const char* nA = has_next ? (const char*)g.A + (size_t)nxt.pm * tstep : cA; const char* nB = has_next ? (const char*)g.Bt + (size_t)nxt.pn * tstep : cB;
        for (int t = 0; t < nt; t += 2) {
            const bool last = (t == nt - 2);
            const char* a1 = cA + (size_t)(t + 1) * kstep;
            const char* a2 = last ? nA : cA + (size_t)(t + 2) * kstep; const char* b2 = last ? nB : cB + (size_t)(t + 2) * kstep;
            const char* a3 = a2 + kstep; const char* b3 = b2 + kstep;
            if (last && has_next) S.a_ready(nxt);
            if constexpr (SP2) {
            PG8_LDB(B0, 0, 0); PG8_LDB(B1, 0, 1); PG8_SCHED; PG8_LDA(At, 0, 0); PG8_STAGE(PG8_SA(1, 1), a1 + hstep, voffA);
            PG8_WAIT_V(8); PG8_WAIT_L(0); PG8_BAR; PG8_MMA(0, 0, At, B0); PG8_MMA(0, 1, At, B1); PG8_BAR; PG8_SCHED;
            PG8_LDA(At, 0, 1); PG8_STAGE(PG8_SB(0, 0), b2, voffB); PG8_STAGE(PG8_SB(0, 1), b2 + hstep, voffB); PG8_STAGE(PG8_SA(0, 0), a2, voffA);
            PG8_WAIT_V(8); PG8_WAIT_L(0); PG8_BAR; PG8_MMA(1, 0, At, B0); PG8_MMA(1, 1, At, B1); PG8_BAR; PG8_SCHED;
            PG8_LDB(B0, 1, 0); PG8_LDB(B1, 1, 1); PG8_SCHED; PG8_LDA(At, 1, 0); PG8_STAGE(PG8_SA(0, 1), a2 + hstep, voffA);
            PG8_WAIT_V(8); PG8_WAIT_L(0); PG8_BAR; PG8_MMA(0, 0, At, B0); PG8_MMA(0, 1, At, B1); PG8_BAR; PG8_SCHED;
            PG8_LDA(At, 1, 1); PG8_STAGE(PG8_SB(1, 0), b3, voffB); PG8_STAGE(PG8_SB(1, 1), b3 + hstep, voffB); PG8_STAGE(PG8_SA(1, 0), a3, voffA);
            PG8_WAIT_V(8); PG8_WAIT_L(0); PG8_BAR; PG8_MMA(1, 0, At, B0); PG8_MMA(1, 1, At, B1); PG8_BAR; PG8_SCHED;
            } else {
            PG8_LDB(B0, 0, 0); PG8_SCHED; PG8_LDA(At, 0, 0); PG8_STAGE(PG8_SA(1, 1), a1 + hstep, voffA);
            PG8_WAIT_L(8); PG8_BAR; PG8_WAIT_L(0); PG8_MMA(0, 0, At, B0); PG8_BAR; PG8_SCHED;
            PG8_LDB(B1, 0, 1); PG8_STAGE(PG8_SB(0, 0), b2, voffB);
            PG8_BAR; PG8_WAIT_L(0); PG8_MMA(0, 1, At, B1); PG8_BAR;
            PG8_LDA(At, 0, 1); PG8_STAGE(PG8_SA(0, 0), a2, voffA);
            PG8_BAR; PG8_WAIT_L(0); PG8_MMA(1, 0, At, B0); PG8_BAR; PG8_SCHED;
            PG8_STAGE(PG8_SB(0, 1), b2 + hstep, voffB);
            PG8_WAIT_V(6); PG8_BAR; PG8_MMA(1, 1, At, B1); PG8_BAR;
            PG8_LDB(B0, 1, 0); PG8_SCHED; PG8_LDA(At, 1, 0); PG8_STAGE(PG8_SA(0, 1), a2 + hstep, voffA);
            PG8_WAIT_L(8); PG8_BAR; PG8_WAIT_L(0); PG8_MMA(0, 0, At, B0); PG8_BAR; PG8_SCHED;
            PG8_LDB(B1, 1, 1); PG8_STAGE(PG8_SB(1, 0), b3, voffB);
            PG8_BAR; PG8_WAIT_L(0); PG8_MMA(0, 1, At, B1); PG8_BAR;
            PG8_LDA(At, 1, 1); PG8_STAGE(PG8_SA(1, 0), a3, voffA);
            PG8_BAR; PG8_WAIT_L(0); PG8_MMA(1, 0, At, B0); PG8_BAR; PG8_SCHED;
            PG8_STAGE(PG8_SB(1, 1), b3 + hstep, voffB);
            PG8_WAIT_V(6); PG8_BAR; PG8_MMA(1, 1, At, B1); PG8_BAR;
            }
        }
        if constexpr (ALIGN_EPI) { if (wr == 0) PG8_BAR; }
        if constexpr (!Epi::AFTER_DRAIN) { E(acc, cur, wr, wc, fr, fq); S.done(cur); }
        if (!has_next) break;
#pragma unroll
        for (int a = 0; a < 2; ++a)
#pragma unroll
            for (int b = 0; b < 2; ++b)
#pragma unroll
                for (int m = 0; m < 4; ++m)
#pragma unroll
                    for (int n = 0; n < 2; ++n) acc[a][b][m][n] = (f32x4){0.f, 0.f, 0.f, 0.f};
        cur = nxt; cA = nA; cB = nB; ++ui;
        if constexpr (ALIGN_EPI) { if (wr == 1) PG8_BAR; }
    }
    PG8_WAIT_V(0);
    if constexpr (!ALIGN_EPI) { if (wr == 0) PG8_BAR; }
    PG8_BAR;
    if constexpr (Epi::AFTER_DRAIN) { E.fused(acc, cur, wr, wc, fr, fq, lds, wid, lane); S.done(cur); }
#undef PG8_SA
#undef PG8_SB
#undef PG8_STAGE
#undef PG8_LDA
#undef PG8_LDB
#undef PG8_MMA
#undef PG8_WAIT_V
#undef PG8_WAIT_L
#undef PG8_BAR
#undef PG8_SCHED
}
}
using pg8::bf16_t; using pg8::bf16x8; using pg8::f32x4; using pg8::u32x4; using pg8::Unit; using pg8::cvt_pk_bf16;
#define LAS __attribute__((address_space(3)))
typedef unsigned u32x2 __attribute__((ext_vector_type(2)));
typedef short s16x4 __attribute__((ext_vector_type(4)));

constexpr int MTOK = 81920, MPROMPT = 65536, DM = 1024, DFF = 2816, NGU = 5632, NZC = 3104  , NZ = 3136  , NZP = 3328;
constexpr int ZQ = 0, ZK = 256, ZV = 512, ZR = 1024, ZAQ = 1536, ZAK = 2048, ZAV = 2560, ZLF = 3072, ZLB = 3088;
constexpr int NCHUNK = 1280;
constexpr float EPS = 1e-6f, LOG2E = 1.4426950408889634f;
constexpr size_t MiB = 1u << 20;
constexpr size_t WS_SSQ = 0, WS_DEC = 2 * MiB, WS_W1GU = 5 * MiB, WS_W1D = 16 * MiB, WS_W2GU = 22 * MiB, WS_W2D = 33 * MiB, WS_WIN = 39 * MiB, WS_WOUT = 46 * MiB,
                 WS_ACTA = 48 * MiB, WS_ST = 208 * MiB, WS_BIG = 368 * MiB, WS_DUMMY = 860 * MiB, WS_BAR = 862 * MiB, WS_END = 863 * MiB;
constexpr int LDS_BYTES = 147456;
constexpr int NTHREADS = 512;

struct Params { const float* in[19]; float* out; unsigned char* ws; };

__device__ __forceinline__ int ltid() { int t = threadIdx.x; asm volatile("" : "+v"(t)); return t; }
__device__ __forceinline__ float bf2f(unsigned short b) { return __uint_as_float((unsigned)b << 16); }
__device__ __forceinline__ unsigned short f2bf(float f) { unsigned u = __float_as_uint(f); return (unsigned short)((u + 0x7fffu + ((u >> 16) & 1u)) >> 16); }
__device__ __forceinline__ float wave_sum(float v) {
#pragma unroll
    for (int o = 1; o < 64; o <<= 1) v += __shfl_xor(v, o);
    return v;
}
__device__ __forceinline__ float quad_max(float x) {
    auto a = __builtin_amdgcn_permlane16_swap(__float_as_uint(x), __float_as_uint(x), false, false); x = fmaxf(__uint_as_float(a[0]), __uint_as_float(a[1]));
    auto b = __builtin_amdgcn_permlane32_swap(__float_as_uint(x), __float_as_uint(x), false, false); return fmaxf(__uint_as_float(b[0]), __uint_as_float(b[1]));
}
__device__ __forceinline__ float quad_sum(float x) {
    auto a = __builtin_amdgcn_permlane16_swap(__float_as_uint(x), __float_as_uint(x), false, false); x = __uint_as_float(a[0]) + __uint_as_float(a[1]);
    auto b = __builtin_amdgcn_permlane32_swap(__float_as_uint(x), __float_as_uint(x), false, false); return __uint_as_float(b[0]) + __uint_as_float(b[1]);
}
__device__ __forceinline__ void lds_barrier() { asm volatile("s_waitcnt lgkmcnt(0)" ::: "memory"); __builtin_amdgcn_s_barrier(); asm volatile("" ::: "memory"); }
#define LDS_WAIT() asm volatile("s_waitcnt lgkmcnt(0)" ::: "memory")

__device__ __forceinline__ void transpose_item(const float* W, int K, int N, bf16_t* WT, int mode, const float* gk, LAS float* scr, int item, int lane) {
    const int nblk = N / 32, kb = item / nblk, nb = item % nblk, k0 = 64 * kb, n0 = 32 * nb;
#pragma unroll 8
    for (int i = 0; i < 32; ++i) { const int kk = 2 * i + (lane >> 5); const float g = gk ? gk[k0 + kk] : 1.0f; scr[kk * 33 + (lane & 31)] = W[(size_t)(k0 + kk) * N + n0 + (lane & 31)] * g; }
    LDS_WAIT(); asm volatile("" ::: "memory");
    const int c = lane & 7;
#pragma unroll
    for (int j = 0; j < 4; ++j) {
        const int n = (lane >> 3) + 8 * j, ns = n0 + n; int drow = ns; float rs = 1.0f;
        if (mode == 1) drow = (ns >> 2) * 8 + (ns & 3);
        else if (mode == 2) drow = (ns >> 2) * 8 + 4 + (ns & 3);
        else if (mode == 3) { drow = ns < 1536 ? ns : (ns < 1568 ? ns + 1536 : ns - 32); if (ns < 256) rs = 0.125f; else if (ns >= 1568 && ns < 2080) rs = 0.125f * LOG2E; }
        const LAS float* s = scr + (8 * c) * 33 + n;
        u32x4 o; o.x = cvt_pk_bf16(s[0 * 33] * rs, s[1 * 33] * rs); o.y = cvt_pk_bf16(s[2 * 33] * rs, s[3 * 33] * rs); o.z = cvt_pk_bf16(s[4 * 33] * rs, s[5 * 33] * rs); o.w = cvt_pk_bf16(s[6 * 33] * rs, s[7 * 33] * rs);
        *(u32x4*)(WT + (size_t)drow * K + k0 + 8 * c) = o;
    }
    LDS_WAIT(); asm volatile("" ::: "memory");
}

__device__ __forceinline__ void prologue(const Params& p, LAS unsigned char* lds) {
    const int tid = ltid(), lane = tid & 63, wave = tid >> 6;
    const int gw = blockIdx.x * 8 + wave, NGW = gridDim.x * 8;
    LAS float* scr = (LAS float*)(lds + wave * 8704);
    unsigned char* ws = p.ws;
    constexpr int I_GU = (DM / 64) * (DFF / 32), I_D = (DFF / 64) * (DM / 32);
    constexpr int NITEMS = 2 * I_GU + I_D;
    for (int it = gw; it < NITEMS; it += NGW) {
        int r = it;
        if (r < I_GU) { transpose_item(p.in[3], DM, DFF, (bf16_t*)(ws + WS_W1GU), 1, p.in[2], scr, r, lane); continue; } r -= I_GU;
        if (r < I_GU) { transpose_item(p.in[4], DM, DFF, (bf16_t*)(ws + WS_W1GU), 2, p.in[2], scr, r, lane); continue; } r -= I_GU;
        transpose_item(p.in[5], DFF, DM, (bf16_t*)(ws + WS_W1D), 0, nullptr, scr, r, lane);
    }
    float* ssq = (float*)(ws + WS_SSQ); bf16_t* xb = (bf16_t*)(ws + WS_ACTA);
    for (int row = gw; row < MTOK; row += 2 * NGW) {
        const int row2 = row + NGW; const bool has2 = row2 < MTOK;
        const float* xr = row < MPROMPT ? p.in[0] + (size_t)row * DM : p.in[1] + (size_t)(row - MPROMPT) * DM;
        const float* xr2 = !has2 ? xr : (row2 < MPROMPT ? p.in[0] + (size_t)row2 * DM : p.in[1] + (size_t)(row2 - MPROMPT) * DM);
        f32x4 v[4], v2[4]; float s = 0.f, s2 = 0.f;
#pragma unroll
        for (int j = 0; j < 4; ++j) { v[j] = ((const f32x4*)xr)[lane + 64 * j]; v2[j] = ((const f32x4*)xr2)[lane + 64 * j]; }
#pragma unroll
        for (int j = 0; j < 4; ++j) { s += (v[j].x * v[j].x + v[j].y * v[j].y) + (v[j].z * v[j].z + v[j].w * v[j].w); s2 += (v2[j].x * v2[j].x + v2[j].y * v2[j].y) + (v2[j].z * v2[j].z + v2[j].w * v2[j].w); }
        s = wave_sum(s); s2 = wave_sum(s2);
#pragma unroll
        for (int j = 0; j < 4; ++j) { u32x2 o; o.x = cvt_pk_bf16(v[j].x, v[j].y); o.y = cvt_pk_bf16(v[j].z, v[j].w); ((u32x2*)(xb + (size_t)row * DM))[lane + 64 * j] = o; }
        if (lane == 0) ssq[row] = s;
        if (has2) {
#pragma unroll
            for (int j = 0; j < 4; ++j) { u32x2 o; o.x = cvt_pk_bf16(v2[j].x, v2[j].y); o.y = cvt_pk_bf16(v2[j].z, v2[j].w); ((u32x2*)(xb + (size_t)row2 * DM))[lane + 64 * j] = o; }
            if (lane == 0) ssq[row2] = s2; }
    }
    const int gt = blockIdx.x * NTHREADS + tid, NGT = gridDim.x * NTHREADS;
    for (int i = gt; i < 3 * MTOK / 4; i += NGT) ((f32x4*)(ssq + MTOK))[i] = (f32x4){0.f, 0.f, 0.f, 0.f};
    u32x4* padp = (u32x4*)((bf16_t*)(ws + WS_WIN) + (size_t)NZC * DM);
    for (int i = gt; i < (NZP - NZC) * DM / 8; i += NGT) padp[i] = (u32x4){0u, 0u, 0u, 0u};
}

__device__ __forceinline__ void deferred_weights(const Params& p, LAS unsigned char* lds, int widx, int nw) {
    const int tid = ltid(), lane = tid & 63, wave = tid >> 6;
    LAS float* scr = (LAS float*)(lds + wave * 8704);
    unsigned char* ws = p.ws;
    constexpr int I_GU = (DM / 64) * (DFF / 32), I_D = (DFF / 64) * (DM / 32), I_IN = (DM / 64) * (NZC / 32), I_OUT = (DM / 64) * (DM / 32);
    constexpr int NITEMS = 2 * I_GU + I_D + I_IN + I_OUT;
    for (int it = widx; it < NITEMS; it += nw) {
        int r = it;
        if (r < I_IN) { transpose_item(p.in[7], DM, NZC, (bf16_t*)(ws + WS_WIN), 3, p.in[6], scr, r, lane); continue; } r -= I_IN;
        if (r < I_OUT) { transpose_item(p.in[13], DM, DM, (bf16_t*)(ws + WS_WOUT), 0, nullptr, scr, r, lane); continue; } r -= I_OUT;
        if (r < I_GU) { transpose_item(p.in[15], DM, DFF, (bf16_t*)(ws + WS_W2GU), 1, p.in[14], scr, r, lane); continue; } r -= I_GU;
        if (r < I_GU) { transpose_item(p.in[16], DM, DFF, (bf16_t*)(ws + WS_W2GU), 2, p.in[14], scr, r, lane); continue; } r -= I_GU;
        transpose_item(p.in[17], DFF, DM, (bf16_t*)(ws + WS_W2D), 0, nullptr, scr, r, lane);
    }
}

__device__ __forceinline__ void lr_gemm_item(const bf16_t* A, const bf16_t* Wt  , const float* ssq, bf16_t* Z, LAS unsigned char* lds, int item) {
    const int tid = ltid(), lane = tid & 63, wave = tid >> 6, fr = lane & 15, quad = lane >> 4; const int row0 = item * 64, k0 = wave * 128 + quad * 8;
    bf16x8 a[4][4], bw[2][4];
#pragma unroll
    for (int rt = 0; rt < 4; ++rt)
#pragma unroll
        for (int ks = 0; ks < 4; ++ks) a[rt][ks] = *(const bf16x8*)(A + (size_t)(row0 + rt * 16 + fr) * DM + k0 + ks * 32);
#pragma unroll
    for (int ct = 0; ct < 2; ++ct)
#pragma unroll
        for (int ks = 0; ks < 4; ++ks) bw[ct][ks] = *(const bf16x8*)(Wt + (size_t)(ct * 16 + fr) * DM + k0 + ks * 32);
    LAS float* part = (LAS float*)lds;
#pragma unroll
    for (int rt = 0; rt < 4; ++rt)
#pragma unroll
        for (int ct = 0; ct < 2; ++ct) { f32x4 acc = {0.f, 0.f, 0.f, 0.f};
#pragma unroll
            for (int ks = 0; ks < 4; ++ks) acc = __builtin_amdgcn_mfma_f32_16x16x32_bf16(a[rt][ks], bw[ct][ks], acc, 0, 0, 0);
#pragma unroll
            for (int j = 0; j < 4; ++j) part[(wave * 64 + rt * 16 + quad * 4 + j) * 32 + ct * 16 + fr] = acc[j]; }
    __syncthreads();
    { const int r = tid >> 3, c4 = (tid & 7) * 4; f32x4 s = {0.f, 0.f, 0.f, 0.f};
#pragma unroll
      for (int w = 0; w < 8; ++w) s += *(const LAS f32x4*)(part + (w * 64 + r) * 32 + c4);
      const float rs = rsqrtf(ssq[row0 + r] * (1.0f / DM) + EPS);
      u32x2 o; o.x = cvt_pk_bf16(s[0] * rs, s[1] * rs); o.y = cvt_pk_bf16(s[2] * rs, s[3] * rs);
      *(u32x2*)(Z + (size_t)(row0 + r) * NZ + ZLF + c4) = o; }
    __syncthreads();
}

struct EpiSwiglu {
    static constexpr bool PERM = true, AFTER_DRAIN = false;
    bf16_t* H; const float* ssq;
    __device__ __forceinline__ void operator()(const f32x4 (&acc)[2][2][4][2], const Unit& u, int wr, int wc, int fr, int fq) const {
        const int row0 = u.pm * 256 + wr * 64 + fr, hc0 = u.pn * 128 + wc * 16 + 4 * fq;
        const int hcs = (fq & 1) ? hc0 + 60 : hc0;
#pragma unroll
        for (int ai = 0; ai < 2; ++ai)
#pragma unroll
            for (int m = 0; m < 4; ++m) {
                const int row = row0 + ai * 128 + m * 16; const float rs = rsqrtf(ssq[row] * (1.0f / DM) + EPS), nrl = -LOG2E * rs, rs2 = rs * rs;
                u32x2 o[2];
#pragma unroll
                for (int bj = 0; bj < 2; ++bj) {
                    const f32x4 ga = acc[ai][bj][m][0], ua = acc[ai][bj][m][1]; float hv[4];
#pragma unroll
                    for (int j = 0; j < 4; ++j) hv[j] = (ga[j] * ua[j]) * (rs2 * __builtin_amdgcn_rcpf(1.0f + __builtin_amdgcn_exp2f(nrl * ga[j])));
                    o[bj].x = cvt_pk_bf16(hv[0], hv[1]); o[bj].y = cvt_pk_bf16(hv[2], hv[3]);
                }
                const auto rx = __builtin_amdgcn_permlane16_swap(o[0].x, o[1].x, false, false), ry = __builtin_amdgcn_permlane16_swap(o[0].y, o[1].y, false, false);
                u32x4 w; w.x = rx[0]; w.y = ry[0]; w.z = rx[1]; w.w = ry[1];
                *(u32x4*)(H + (size_t)row * DFF + hcs) = w;
            }
    }
};
template <bool BASE_BF16> struct EpiResid {
    static constexpr bool PERM = true, AFTER_DRAIN = false;
    const float* base0; const float* base1; int split; const bf16_t* baseb; bf16_t* ob; float* ssq; float alpha;
    __device__ __forceinline__ void operator()(const f32x4 (&acc)[2][2][4][2], const Unit& u, int wr, int wc, int fr, int fq) const {
        const int row0 = u.pm * 256 + wr * 64 + fr, c00 = u.pn * 256 + wc * 32 + 8 * fq;
        float ssum[2][4];
#pragma unroll
        for (int ai = 0; ai < 2; ++ai)
#pragma unroll
            for (int m = 0; m < 4; ++m) {
                const int row = row0 + ai * 128 + m * 16;
                float s = 0.f;
#pragma unroll
                for (int bj = 0; bj < 2; ++bj) {
                    const int c0 = c00 + bj * 128; f32x4 b0, b1;
                    if constexpr (BASE_BF16) { const u32x4 r = *(const u32x4*)(baseb + (size_t)row * DM + c0);
                        b0 = (f32x4){__uint_as_float(r.x << 16), __uint_as_float(r.x & 0xffff0000u), __uint_as_float(r.y << 16), __uint_as_float(r.y & 0xffff0000u)};
                        b1 = (f32x4){__uint_as_float(r.z << 16), __uint_as_float(r.z & 0xffff0000u), __uint_as_float(r.w << 16), __uint_as_float(r.w & 0xffff0000u)};
                    } else { const float* b = row < split ? base0 + (size_t)row * DM : base1 + (size_t)(row - split) * DM; b0 = *(const f32x4*)(b + c0); b1 = *(const f32x4*)(b + c0 + 4); }
                    const f32x4 v0 = b0 + acc[ai][bj][m][0] * alpha, v1 = b1 + acc[ai][bj][m][1] * alpha;
                    u32x4 w; w.x = cvt_pk_bf16(v0[0], v0[1]); w.y = cvt_pk_bf16(v0[2], v0[3]); w.z = cvt_pk_bf16(v1[0], v1[1]); w.w = cvt_pk_bf16(v1[2], v1[3]); *(u32x4*)(ob + (size_t)row * DM + c0) = w;
                    s += (v0[0] * v0[0] + v0[1] * v0[1]) + (v0[2] * v0[2] + v0[3] * v0[3]) + (v1[0] * v1[0] + v1[1] * v1[1]) + (v1[2] * v1[2] + v1[3] * v1[3]);
                }
                ssum[ai][m] = quad_sum(s);
            }
#pragma unroll
        for (int ai = 0; ai < 2; ++ai) { const float v = fq == 0 ? ssum[ai][0] : fq == 1 ? ssum[ai][1] : fq == 2 ? ssum[ai][2] : ssum[ai][3];
            atomicAdd(ssq + row0 + ai * 128 + fq * 16, v); }
    }
};
struct EpiZ {
    static constexpr bool PERM = true, AFTER_DRAIN = false;
    bf16_t* Z; const float* ssq;
    __device__ __forceinline__ void operator()(const f32x4 (&acc)[2][2][4][2], const Unit& u, int wr, int wc, int fr, int fq) const {
        const int row0 = u.pm * 256 + wr * 64 + fr, c00 = u.pn * 256 + wc * 32 + 8 * fq;
#pragma unroll
        for (int ai = 0; ai < 2; ++ai)
#pragma unroll
            for (int m = 0; m < 4; ++m) {
                const int row = row0 + ai * 128 + m * 16; const float rs = rsqrtf(ssq[row] * (1.0f / DM) + EPS);
#pragma unroll
                for (int bj = 0; bj < 2; ++bj) {
                    const int c0 = c00 + bj * 128;
                    if (c0 < NZC) { const f32x4 v0 = acc[ai][bj][m][0] * rs, v1 = acc[ai][bj][m][1] * rs;
                        u32x4 w; w.x = cvt_pk_bf16(v0[0], v0[1]); w.y = cvt_pk_bf16(v0[2], v0[3]); w.z = cvt_pk_bf16(v1[0], v1[1]); w.w = cvt_pk_bf16(v1[2], v1[3]);
                        *(u32x4*)(Z + (size_t)row * NZ + c0) = w; }
                }
            }
    }
};
#define XB_TMO      128
#define XB_XCNT(j)  (256  + 64 * (j))
#define XB_XSUB(j)  (1280 + 64 * (j))
#define XB_XGEN(j)  (2304 + 64 * (j))
#define XB_TOP      3328
#define XB_TOPGEN   3392
#define XCD_BAR_WORDS 3456
#define XB_SPIN_CAP (1u << 18)

__device__ __forceinline__ unsigned xb_ld(unsigned* p)              { return __hip_atomic_load(p, __ATOMIC_RELAXED, __HIP_MEMORY_SCOPE_AGENT); }
__device__ __forceinline__ unsigned xb_add(unsigned* p, unsigned v) { return __hip_atomic_fetch_add(p, v, __ATOMIC_RELAXED, __HIP_MEMORY_SCOPE_AGENT); }
__device__ __forceinline__ unsigned xb_xcc_id() { return (unsigned)__builtin_amdgcn_s_getreg((3 << 11) | 20) & 0xFu; }
#define XB_SPIN(cond, bar) do { unsigned _sp = 0; while (cond) { __builtin_amdgcn_s_sleep(1); \
    if ((++_sp & 255u) == 0u) { if (xb_ld(&(bar)[XB_TMO])) break; if (_sp > XB_SPIN_CAP) { atomicAdd(&(bar)[XB_TMO], 1u); break; } } } } while (0)

struct XcdBarrier {
    unsigned* bar; unsigned x;
    volatile LAS unsigned* st;
};

__device__ __forceinline__ XcdBarrier xcd_barrier_post(unsigned* bar, volatile LAS unsigned* st) {
    XcdBarrier b; b.bar = bar; b.x = xb_xcc_id(); b.st = st;
    if (threadIdx.x == 0) (void)xb_add(&bar[XB_XCNT(b.x)], 1u);
    return b;
}
__device__ __forceinline__ void xcd_barrier_complete(unsigned* bar, unsigned x, unsigned& nloc, unsigned& nx) {
    const unsigned G = gridDim.x * gridDim.y * gridDim.z;
    unsigned sum, cnt, mine, sp = 0u;
    for (;;) {
        sum = 0u; cnt = 0u; mine = 0u;
#pragma unroll
        for (unsigned j = 0; j < 16; ++j) { const unsigned c = xb_ld(&bar[XB_XCNT(j)]); sum += c; cnt += (c > 0u) ? 1u : 0u; mine = (j == x) ? c : mine; }
        if (sum == G) break;
        __builtin_amdgcn_s_sleep(1);
        if ((++sp & 255u) == 0u) { if (xb_ld(&bar[XB_TMO])) break; if (sp > XB_SPIN_CAP) { atomicAdd(&bar[XB_TMO], 1u); break; } }
    }
    nloc = mine > 0u ? mine : 1u; nx = cnt > 0u ? cnt : 1u;
}

__device__ __forceinline__ void xcd_barrier(const XcdBarrier& b) {
    asm volatile("s_waitcnt vmcnt(0)" ::: "memory");
    __syncthreads();
    if (threadIdx.x == 0) {
        unsigned* bar = b.bar;
        __builtin_amdgcn_s_waitcnt(0);
        unsigned nloc = b.st[0], nx = b.st[1];
        if (nloc == 0u) { xcd_barrier_complete(bar, b.x, nloc, nx); b.st[0] = nloc; b.st[1] = nx; }
        const unsigned old = xb_add(&bar[XB_XSUB(b.x)], 1u);
        const unsigned gen = old / nloc;
        if (old + 1u == (gen + 1u) * nloc) {
            __builtin_amdgcn_fence(__ATOMIC_RELEASE, "agent");
            asm volatile("s_waitcnt vmcnt(0)" ::: "memory");
            const unsigned og = xb_add(&bar[XB_TOP], 1u);
            const unsigned tg = og / nx;
            if (og + 1u == (tg + 1u) * nx) xb_add(&bar[XB_TOPGEN], 1u);
            else XB_SPIN(xb_ld(&bar[XB_TOPGEN]) == tg, bar);
            __builtin_amdgcn_fence(__ATOMIC_ACQUIRE, "agent");
            xb_add(&bar[XB_XGEN(b.x)], 1u);
            asm volatile("s_waitcnt vmcnt(0)" ::: "memory");
        } else {
            XB_SPIN(xb_ld(&bar[XB_XGEN(b.x)]) == gen, bar);
            __builtin_amdgcn_fence(__ATOMIC_ACQUIRE, "agent");
            asm volatile("s_waitcnt vmcnt(0)" ::: "memory");
        }
    }
    __syncthreads();
}

#define MFMA16(a, b, c) __builtin_amdgcn_mfma_f32_16x16x32_bf16((a), (b), (c), 0, 0, 0)
typedef __bf16 bf2_t __attribute__((ext_vector_type(2)));
__device__ __forceinline__ float dot2bf(unsigned a, unsigned b, float c) { return __builtin_amdgcn_fdot2_f32_bf16(__builtin_bit_cast(bf2_t, a), __builtin_bit_cast(bf2_t, b), c, false); }
__device__ __forceinline__ bf16_t f2bf1(float x) { return (bf16_t)cvt_pk_bf16(x, 0.f); }
constexpr int GL_LR = 0  , GL_WA = 8192, GL_BA = 16384, GL_TOT = 16896, GL_VT = 18944  , GL_A = 37376  , GL_P = 74240  , GL_SS = 83456  , GL_KR = 85504  , GL_QR = 94720  ;

__device__ __forceinline__ void gla_load(const Params& p, const bf16_t* Z, LAS unsigned char* lds, int gc, int h, bool withq) {
    const int tid = ltid(); const size_t tok0 = (size_t)gc * 64;
    LAS unsigned* lr = (LAS unsigned*)(lds + GL_LR); LAS float* wa = (LAS float*)(lds + GL_WA); LAS float* ba = (LAS float*)(lds + GL_BA); LAS bf16_t* vT = (LAS bf16_t*)(lds + GL_VT);
    { const int t = tid >> 3, r4 = (tid & 7) * 4; const u32x2 raw = *(const u32x2*)(Z + (tok0 + t) * NZ + ZLF + r4);
      *(LAS u32x2*)(lr + ((r4 >> 4) * 64 + t) * 8 + ((r4 & 15) >> 1)) = raw; }
    { const int dir = tid >> 8, r = (tid >> 4) & 15, kk4 = (tid & 15) * 4; const float* src = (dir ? p.in[10] : p.in[8]) + r * 256 + h * 64 + kk4;
      *(LAS f32x4*)(wa + (dir * 16 + r) * 64 + kk4) = *(const f32x4*)src; }
    { const int t = tid >> 3, k8 = (tid & 7) * 8;
      *(LAS u32x4*)(lds + GL_KR + (t * 72 + k8) * 2) = *(const u32x4*)(Z + (tok0 + t) * NZ + ZK + h * 64 + k8);
      if (withq) *(LAS u32x4*)(lds + GL_QR + (t * 72 + k8) * 2) = *(const u32x4*)(Z + (tok0 + t) * NZ + ZQ + h * 64 + k8); }
    if (tid < 128) { const int dir = tid >> 6, kk = tid & 63; ba[dir * 64 + kk] = (dir ? p.in[11] : p.in[9])[h * 64 + kk]; }
    { const int t = tid >> 3, dv0 = (tid & 7) * 16; const u32x4* src = (const u32x4*)(Z + (tok0 + t) * NZ + ZV + h * 128 + dv0); const u32x4 a = src[0], b = src[1];
      const unsigned wv[8] = {a.x, a.y, a.z, a.w, b.x, b.y, b.z, b.w};
#pragma unroll
      for (int e = 0; e < 8; ++e) { vT[(dv0 + 2 * e) * 72 + t] = (bf16_t)(wv[e] & 0xffffu); vT[(dv0 + 2 * e + 1) * 72 + t] = (bf16_t)(wv[e] >> 16); } }
    __syncthreads();
}
__device__ __forceinline__ void gla_gates(LAS unsigned char* lds, float (&c)[16], float (&la)[16], float& off, float& all) {
    const int tid = ltid(), dir = tid >> 8, qtr = (tid >> 6) & 3, kk = tid & 63;
    LAS unsigned* lr = (LAS unsigned*)(lds + GL_LR); LAS float* wa = (LAS float*)(lds + GL_WA); LAS float* ba = (LAS float*)(lds + GL_BA); LAS float* tot = (LAS float*)(lds + GL_TOT);
    unsigned w2[8];
#pragma unroll
    for (int r = 0; r < 8; ++r) w2[r] = cvt_pk_bf16(wa[(dir * 16 + 2 * r) * 64 + kk], wa[(dir * 16 + 2 * r + 1) * 64 + kk]);
    const float bias = ba[dir * 64 + kk]; float run = 0.f;
#pragma unroll
    for (int gb = 0; gb < 2; ++gb) {
        u32x4 L[8][2];
#pragma unroll
        for (int i = 0; i < 8; ++i) { const LAS u32x4* l4 = (const LAS u32x4*)(lr + (dir * 64 + qtr * 16 + gb * 8 + i) * 8); L[i][0] = l4[0]; L[i][1] = l4[1]; }
        asm volatile("s_waitcnt lgkmcnt(0)" ::: "memory");
#pragma unroll
        for (int i = 0; i < 8; ++i) { const u32x4 v0 = L[i][0], v1 = L[i][1];
            float x = bias, y = 0.f;
            x = dot2bf(v0.x, w2[0], x); y = dot2bf(v0.y, w2[1], y); x = dot2bf(v0.z, w2[2], x); y = dot2bf(v0.w, w2[3], y);
            x = dot2bf(v1.x, w2[4], x); y = dot2bf(v1.y, w2[5], y); x = dot2bf(v1.z, w2[6], x); y = dot2bf(v1.w, w2[7], y);
            x += y;
            const float li = -(fmaxf(-x, 0.f) + 0.6931471805599453f * __builtin_amdgcn_logf(1.0f + __builtin_amdgcn_exp2f(-LOG2E * fabsf(x)))) * (1.0f / 16.0f);
            run += li; c[gb * 8 + i] = run; la[gb * 8 + i] = li; }
    }
    tot[(dir * 4 + qtr) * 64 + kk] = run;
    lds_barrier();
    off = 0.f; all = 0.f;
#pragma unroll
    for (int q = 0; q < 4; ++q) { const float v = tot[(dir * 4 + q) * 64 + kk]; all += v; if (q < qtr) off += v; }
}

__device__ __forceinline__ unsigned gla_touch(const Params& p, int un, bool states) {
    const bf16_t* Z = (const bf16_t*)(p.ws + WS_BIG); const int tid = ltid(); unsigned r = 0u;
    if (GLA_TOUCH && un < NCHUNK * 4) { const int gc = un >> 2, h = un & 3;
        if (tid < 448) { const int t = tid & 63, w = tid >> 6; const int col = w == 0 ? ZQ + h * 64 : w == 1 ? ZK + h * 64 : w == 2 ? ZV + h * 128 : w == 3 ? ZV + h * 128 + 64 : w == 4 ? ZR + h * 128 : w == 5 ? ZR + h * 128 + 64 : ZLF;
            r = *(const unsigned*)(Z + ((size_t)gc * 64 + t) * NZ + col); }
        if (states && tid < 256) r ^= *(const unsigned*)((const bf16_t*)(p.ws + WS_ST) + (size_t)(gc * 4 + h) * 2 * 8192 + tid * 64); }
    return r;
}
__device__ __forceinline__ void gla_g1_unit(const Params& p, LAS unsigned char* lds, int gc, int h, int un) {
    const bf16_t* Z = (const bf16_t*)(p.ws + WS_BIG); bf16_t* ST = (bf16_t*)(p.ws + WS_ST); float* DEC = (float*)(p.ws + WS_DEC);
    const int tid = ltid(), lane = tid & 63, wave = tid >> 6, dir = tid >> 8, qtr = (tid >> 6) & 3, kk = tid & 63; const size_t tok0 = (size_t)gc * 64;
    gla_load(p, Z, lds, gc, h, false);
    const unsigned pfv = gla_touch(p, un, false);
    const LAS bf16_t* kraw = (const LAS bf16_t*)(lds + GL_KR) + (qtr * 16) * 72 + kk;
    float c[16], la[16], off, all; gla_gates(lds, c, la, off, all);
    LAS bf16_t* KeT = (LAS bf16_t*)(lds + GL_A);
#pragma unroll
    for (int i = 0; i < 16; ++i) { const int t = qtr * 16 + i; const float e = __builtin_amdgcn_exp2f(LOG2E * (dir == 0 ? all - (off + c[i]) : off + c[i] - la[i]));
        KeT[(dir * 64 + kk) * 72 + t] = f2bf1(bf2f(kraw[i * 72]) * e); }
    if (qtr == 0) DEC[((size_t)(gc * 4 + h) * 2 + dir) * 64 + kk] = __builtin_amdgcn_exp2f(LOG2E * all);
    lds_barrier();
    { const LAS bf16_t* vT = (const LAS bf16_t*)(lds + GL_VT); const int wd = wave >> 2, wq = wave & 3, fr = lane & 15, quad = lane >> 4;
      bf16_t* dst = ST + ((size_t)(gc * 4 + h) * 2 + wd) * 8192;
#pragma unroll
      for (int dd = 0; dd < 2; ++dd) { const int dvt = 2 * wq + dd; bf16x8 b[2];
#pragma unroll
        for (int ks = 0; ks < 2; ++ks) b[ks] = *(const LAS bf16x8*)(vT + (dvt * 16 + fr) * 72 + ks * 32 + quad * 8);
#pragma unroll
        for (int kp = 0; kp < 2; ++kp) { u32x2 o[2];
#pragma unroll
          for (int kq = 0; kq < 2; ++kq) { const int kt = 2 * kp + kq; f32x4 acc = {0.f, 0.f, 0.f, 0.f};
#pragma unroll
            for (int ks = 0; ks < 2; ++ks) { const bf16x8 a = *(const LAS bf16x8*)(KeT + (wd * 64 + kt * 16 + fr) * 72 + ks * 32 + quad * 8); acc = MFMA16(a, b[ks], acc); }
            o[kq].x = cvt_pk_bf16(acc[0], acc[1]); o[kq].y = cvt_pk_bf16(acc[2], acc[3]); }
          const auto rx = __builtin_amdgcn_permlane16_swap(o[0].x, o[1].x, false, false), ry = __builtin_amdgcn_permlane16_swap(o[0].y, o[1].y, false, false);
          u32x4 w; w.x = rx[0]; w.y = ry[0]; w.z = rx[1]; w.w = ry[1];
          const int ko = (quad & 1) ? (2 * kp + 1) * 16 + (quad - 1) * 4 : (2 * kp) * 16 + quad * 4;
          *(u32x4*)(dst + (dvt * 16 + fr) * 64 + ko) = w; } } }
    ((unsigned*)(p.ws + WS_DUMMY))[blockIdx.x * NTHREADS + tid] = pfv;
    lds_barrier();
}

template <int EL, int NB> __device__ __forceinline__ void g2_scan(bf16_t* ST, const float* DEC, int c0, int n, int h, int dir, int eo) {
    const int k0 = eo & 63;
    float S[EL];
#pragma unroll
    for (int e = 0; e < EL; ++e) S[e] = 0.f;
    for (int i0 = 0; i0 < n; i0 += NB) {
        unsigned kv[NB][EL / 2]; float d[NB][EL];
#pragma unroll
        for (int u = 0; u < NB; ++u) { const int i = i0 + u, c = dir == 0 ? c0 + i : c0 + n - 1 - i; const size_t slot = (size_t)(c * 4 + h) * 2 + dir;
            if constexpr (EL == 8) { const u32x4 t = *(const u32x4*)(ST + slot * 8192 + eo); kv[u][0] = t.x; kv[u][1] = t.y; kv[u][2] = t.z; kv[u][3] = t.w; }
            else { const u32x2 t = *(const u32x2*)(ST + slot * 8192 + eo); kv[u][0] = t.x; kv[u][1] = t.y; }
#pragma unroll
            for (int q = 0; q < EL / 4; ++q) { const f32x4 t = *(const f32x4*)(DEC + slot * 64 + k0 + 4 * q); d[u][4 * q] = t[0]; d[u][4 * q + 1] = t[1]; d[u][4 * q + 2] = t[2]; d[u][4 * q + 3] = t[3]; } }
#pragma unroll
        for (int u = 0; u < NB; ++u) {
            const int i = i0 + u, c = dir == 0 ? c0 + i : c0 + n - 1 - i; const size_t slot = (size_t)(c * 4 + h) * 2 + dir;
            if constexpr (EL == 8) { u32x4 o; o.x = cvt_pk_bf16(S[0], S[1]); o.y = cvt_pk_bf16(S[2], S[3]); o.z = cvt_pk_bf16(S[4], S[5]); o.w = cvt_pk_bf16(S[6], S[7]); *(u32x4*)(ST + slot * 8192 + eo) = o; }
            else { u32x2 o; o.x = cvt_pk_bf16(S[0], S[1]); o.y = cvt_pk_bf16(S[2], S[3]); *(u32x2*)(ST + slot * 8192 + eo) = o; }
#pragma unroll
            for (int e = 0; e < EL / 2; ++e) { S[2 * e] = d[u][2 * e] * S[2 * e] + __uint_as_float(kv[u][e] << 16); S[2 * e + 1] = d[u][2 * e + 1] * S[2 * e + 1] + __uint_as_float(kv[u][e] & 0xffff0000u); }
        }
    }
}
__device__ __forceinline__ void gla_g2(const Params& p) {
    bf16_t* ST = (bf16_t*)(p.ws + WS_ST); const float* DEC = (const float*)(p.ws + WS_DEC);
    const int tid = ltid(), lane = tid & 63, wave = tid >> 6; const int gw = blockIdx.x * 8 + wave, NGW = gridDim.x * 8;
    if (gw < 256) { const int r = gw, h = r >> 6, dir = (r >> 5) & 1, part = r & 31; g2_scan<4, 16>(ST, DEC, 1024, 256, h, dir, part * 256 + lane * 4); }
    else if (NGW > 256) for (int it = gw - 256; it < 4096; it += NGW - 256) { const int c0 = (it >> 7) * 32, r = it & 127, h = r >> 5, dir = (r >> 4) & 1, part = r & 15; g2_scan<8, 8>(ST, DEC, c0, 32, h, dir, part * 512 + lane * 8); }
}

__device__ __forceinline__ void gla_g3_unit(const Params& p, LAS unsigned char* lds, int gc, int h, int un) {
    const bf16_t* Z = (const bf16_t*)(p.ws + WS_BIG); const bf16_t* ST = (const bf16_t*)(p.ws + WS_ST); bf16_t* OC = (bf16_t*)(p.ws + WS_ACTA);
    const int tid = ltid(), lane = tid & 63, wave = tid >> 6, dir = tid >> 8, qtr = (tid >> 6) & 3, kk = tid & 63, fr = lane & 15, quad = lane >> 4; const size_t tok0 = (size_t)gc * 64;
    u32x2 rr[4]; bf16x8 bf_[2], bb[2];
#pragma unroll
    for (int ti = 0; ti < 4; ++ti) rr[ti] = *(const u32x2*)(Z + (tok0 + ti * 16 + fr) * NZ + ZR + h * 128 + wave * 16 + quad * 4);
    { const bf16_t* Sf = ST + ((size_t)(gc * 4 + h) * 2 + 0) * 8192; const bf16_t* Sb = Sf + 8192;
#pragma unroll
      for (int ks = 0; ks < 2; ++ks) { const int o = ks * 32 + quad * 8; bf_[ks] = *(const bf16x8*)(Sf + (wave * 16 + fr) * 64 + o); bb[ks] = *(const bf16x8*)(Sb + (wave * 16 + fr) * 64 + o); } }
    gla_load(p, Z, lds, gc, h, true);
    const unsigned pfv = gla_touch(p, un, true);
    const LAS bf16_t* kraw = (const LAS bf16_t*)(lds + GL_KR) + (qtr * 16) * 72 + kk; const LAS bf16_t* qraw = (const LAS bf16_t*)(lds + GL_QR) + (qtr * 16) * 72 + kk;
    float c[16], la[16], off, all; gla_gates(lds, c, la, off, all);
    LAS bf16_t* QK = (LAS bf16_t*)(lds + GL_A);
    { LAS bf16_t* Qd = QK + (dir * 2) * 64 * 72; LAS bf16_t* Kd = Qd + 64 * 72;
#pragma unroll
      for (int i = 0; i < 16; ++i) { const int t = qtr * 16 + i; const float b = dir == 0 ? off + c[i] : all - (off + c[i]) + la[i];
        const float b2 = LOG2E * b; Qd[t * 72 + kk] = f2bf1(bf2f(qraw[i * 72]) * __builtin_amdgcn_exp2f(b2)); Kd[t * 72 + kk] = f2bf1(bf2f(kraw[i * 72]) * __builtin_amdgcn_exp2f(-b2)); } }
    lds_barrier();
    const LAS bf16_t* Qf = QK; const LAS bf16_t* Kf = QK + 64 * 72; const LAS bf16_t* Qb = QK + 2 * 64 * 72; const LAS bf16_t* Kb = QK + 3 * 64 * 72;
    LAS bf16_t* P = (LAS bf16_t*)(lds + GL_P); const LAS bf16_t* vT = (const LAS bf16_t*)(lds + GL_VT);
#pragma unroll
    for (int pp = 0; pp < 2; ++pp) { const int pt = 2 * wave + pp, ti = pt >> 2, tj = pt & 3; f32x4 af = {0.f, 0.f, 0.f, 0.f}, ab = {0.f, 0.f, 0.f, 0.f};
#pragma unroll
        for (int ks = 0; ks < 2; ++ks) { const int o = ks * 32 + quad * 8;
            af = MFMA16(*(const LAS bf16x8*)(Kf + (tj * 16 + fr) * 72 + o), *(const LAS bf16x8*)(Qf + (ti * 16 + fr) * 72 + o), af);
            ab = MFMA16(*(const LAS bf16x8*)(Kb + (tj * 16 + fr) * 72 + o), *(const LAS bf16x8*)(Qb + (ti * 16 + fr) * 72 + o), ab); }
        float pv[4];
#pragma unroll
        for (int j = 0; j < 4; ++j) { const int s = tj * 16 + quad * 4 + j, t = ti * 16 + fr; pv[j] = (s <= t ? af[j] : 0.f) + (s >= t ? ab[j] : 0.f); }
        u32x2 o; o.x = cvt_pk_bf16(pv[0], pv[1]); o.y = cvt_pk_bf16(pv[2], pv[3]);
        *(LAS u32x2*)(P + (ti * 16 + fr) * 72 + tj * 16 + quad * 4) = o; }
    ((unsigned*)(p.ws + WS_DUMMY))[blockIdx.x * NTHREADS + tid] = pfv;
    lds_barrier();
    f32x4 acc[4];
    { bf16x8 av[2];
#pragma unroll
      for (int ks = 0; ks < 2; ++ks) av[ks] = *(const LAS bf16x8*)(vT + (wave * 16 + fr) * 72 + ks * 32 + quad * 8);
#pragma unroll
      for (int ti = 0; ti < 4; ++ti) { f32x4 a = {0.f, 0.f, 0.f, 0.f};
#pragma unroll
          for (int ks = 0; ks < 2; ++ks) { const int o = ks * 32 + quad * 8;
              a = MFMA16(av[ks], *(const LAS bf16x8*)(P + (ti * 16 + fr) * 72 + o), a);
              a = MFMA16(bf_[ks], *(const LAS bf16x8*)(Qf + (ti * 16 + fr) * 72 + o), a);
              a = MFMA16(bb[ks], *(const LAS bf16x8*)(Qb + (ti * 16 + fr) * 72 + o), a); }
          acc[ti] = a; } }
    LAS float* ssw = (LAS float*)(lds + GL_SS);
#pragma unroll
    for (int ti = 0; ti < 4; ++ti) { float s = (acc[ti][0] * acc[ti][0] + acc[ti][1] * acc[ti][1]) + (acc[ti][2] * acc[ti][2] + acc[ti][3] * acc[ti][3]);
        s = quad_sum(s); if (quad == 0) ssw[wave * 64 + ti * 16 + fr] = s; }
    lds_barrier();
    { const int dv0 = h * 128 + wave * 16 + quad * 4; const f32x4 g = *(const f32x4*)(p.in[12] + dv0);
      u32x2 oo[4];
#pragma unroll
      for (int ti = 0; ti < 4; ++ti) { const int t = ti * 16 + fr; float tot = 0.f;
#pragma unroll
          for (int w8 = 0; w8 < 8; ++w8) tot += ssw[w8 * 64 + t];
          const float rinv = rsqrtf(tot * (1.0f / 128.0f) + EPS);
          const float r0 = __uint_as_float(rr[ti].x << 16), r1 = __uint_as_float(rr[ti].x & 0xffff0000u), r2 = __uint_as_float(rr[ti].y << 16), r3 = __uint_as_float(rr[ti].y & 0xffff0000u);
#define SILU_(r_) ((r_) * __builtin_amdgcn_rcpf(1.0f + __builtin_amdgcn_exp2f(-LOG2E * (r_))))
          oo[ti].x = cvt_pk_bf16(acc[ti][0] * rinv * g[0] * SILU_(r0), acc[ti][1] * rinv * g[1] * SILU_(r1));
          oo[ti].y = cvt_pk_bf16(acc[ti][2] * rinv * g[2] * SILU_(r2), acc[ti][3] * rinv * g[3] * SILU_(r3));
#undef SILU_
      }
#pragma unroll
      for (int tp = 0; tp < 2; ++tp) {
          const auto rx = __builtin_amdgcn_permlane16_swap(oo[2 * tp].x, oo[2 * tp + 1].x, false, false), ry = __builtin_amdgcn_permlane16_swap(oo[2 * tp].y, oo[2 * tp + 1].y, false, false);
          u32x4 w; w.x = rx[0]; w.y = ry[0]; w.z = rx[1]; w.w = ry[1];
          const int t = ((quad & 1) ? 2 * tp + 1 : 2 * tp) * 16 + fr, dvs = (quad & 1) ? dv0 - 4 : dv0;
          *(u32x4*)(OC + (tok0 + t) * DM + dvs) = w; } }
    lds_barrier();
}
constexpr int AT_TILE = 512, AT_O = 0  , AT_M = AT_TILE * 68 * 4, AT_L = AT_M + AT_TILE * 4;
__device__ __forceinline__ void attn_group(int br, int g, int p0, int& cls, int& qi) {
    if (br == 0) { cls = 0; qi = p0 + 32 * g; } else if (br == 1) { cls = g >> 2; qi = (p0 >> 2) + 32 * (g & 3); } else { cls = g; qi = p0 >> 4; }
}
__device__ __forceinline__ void attn_load(const bf16_t* Zh, int s0, int sh, int n, int cls, int kb, int lane, bf16x8 (&k)[4], bf16x8 (&v)[4]) {
    const int fr = lane & 15, quad = lane >> 4;
    if (kb >= 0 && kb + 32 <= n) {
        const unsigned o0 = (unsigned)(s0 + ((kb + fr) << sh) + cls) * (unsigned)NZ + quad * 8, o1 = o0 + ((unsigned)(16 << sh)) * (unsigned)NZ;
        k[0] = *(const bf16x8*)(Zh + o0 + ZAK); k[1] = *(const bf16x8*)(Zh + o0 + ZAK + 32); v[0] = *(const bf16x8*)(Zh + o0 + ZAV); v[1] = *(const bf16x8*)(Zh + o0 + ZAV + 32);
        k[2] = *(const bf16x8*)(Zh + o1 + ZAK); k[3] = *(const bf16x8*)(Zh + o1 + ZAK + 32); v[2] = *(const bf16x8*)(Zh + o1 + ZAV); v[3] = *(const bf16x8*)(Zh + o1 + ZAV + 32);
    } else {
#pragma unroll
        for (int kt = 0; kt < 2; ++kt) { int ki = kb + kt * 16 + fr; ki = ki < 0 ? 0 : (ki >= n ? n - 1 : ki);
            const bf16_t* r = Zh + (unsigned)(s0 + (ki << sh) + cls) * (unsigned)NZ + quad * 8;
            k[kt * 2] = *(const bf16x8*)(r + ZAK); k[kt * 2 + 1] = *(const bf16x8*)(r + ZAK + 32); v[kt * 2] = *(const bf16x8*)(r + ZAV); v[kt * 2 + 1] = *(const bf16x8*)(r + ZAV + 32); }
    }
}
__device__ __forceinline__ void attn_unit(const Params& p, LAS unsigned char* lds, int tile, int h, int variant) {
    const bf16_t* Zh = (const bf16_t*)(p.ws + WS_BIG) + h * 64; bf16_t* OC = (bf16_t*)(p.ws + WS_ACTA);
    const int tid = ltid(), lane = tid & 63, wave = tid >> 6, fr = lane & 15, quad = lane >> 4;
    const int T0 = tile * AT_TILE, s0 = T0 < MPROMPT ? (T0 & ~2047) : MPROMPT, L = T0 < MPROMPT ? 2048 : 16384, p0 = T0 - s0;
    LAS float* Ol = (LAS float*)(lds + AT_O); LAS float* ml = (LAS float*)(lds + AT_M); LAS float* ll = (LAS float*)(lds + AT_L);
    const float slope2 = exp2f(-(float)(h + 1)) * LOG2E;
    bf16x8 isel[2];
#pragma unroll
    for (int hf = 0; hf < 2; ++hf)
#pragma unroll
        for (int jj = 0; jj < 8; ++jj) isel[hf][jj] = (quad * 8 + jj == hf * 16 + fr) ? (short)0x3F80 : (short)0;
#pragma unroll 1
    for (int br = 0; br < 3; ++br) {
        const int sh = 2 * br, n = L >> sh; const float nbc = -slope2 * (float)(1 << sh);
        bf16x8 kf[4], vf[4];
        { int cls, qi; attn_group(br, 2 * wave, p0, cls, qi); attn_load(Zh, s0, sh, n, cls, qi - 64, lane, kf, vf); }
        bf16x8 qf[2][2]; float m[2], l[2]; f32x4 O[2][4]; int tq[2], tl[2];
#pragma unroll
        for (int nt = 0; nt < 2; ++nt) { m[nt] = -1e30f; l[nt] = 0.f; tq[nt] = 0; tl[nt] = 0; qf[nt][0] = kf[0]; qf[nt][1] = kf[0];
#pragma unroll
            for (int dt = 0; dt < 4; ++dt) O[nt][dt] = (f32x4){0.f, 0.f, 0.f, 0.f}; }
#pragma unroll 1
        for (int it = 0; it < 10; ++it) {
            const int gg = it >= 5 ? 1 : 0, ch = it - 5 * gg;
            int cls, qi; attn_group(br, 2 * wave + gg, p0, cls, qi);
            if (ch == 0) {
#pragma unroll
                for (int nt = 0; nt < 2; ++nt) {
                    tq[nt] = s0 + ((qi + 16 * nt + fr) << sh) + cls; tl[nt] = tq[nt] - T0;
#pragma unroll
                    for (int ks = 0; ks < 2; ++ks) qf[nt][ks] = *(const bf16x8*)(Zh + (unsigned)tq[nt] * (unsigned)NZ + ZAQ + ks * 32 + quad * 8);
                    if (br == 0) { m[nt] = -1e30f; l[nt] = 0.f;
#pragma unroll
                        for (int dt = 0; dt < 4; ++dt) O[nt][dt] = (f32x4){0.f, 0.f, 0.f, 0.f};
                    } else { m[nt] = ml[tl[nt]]; l[nt] = quad == 0 ? ll[tl[nt]] : 0.f;
#pragma unroll
                        for (int dt = 0; dt < 4; ++dt) O[nt][dt] = *(const LAS f32x4*)(Ol + tl[nt] * 68 + dt * 16 + quad * 4); }
                }
            }
            const int kb = qi - 64 + 32 * ch;
            f32x4 S[2][2], vt[2][4];
#pragma unroll
            for (int nt = 0; nt < 2; ++nt)
#pragma unroll
                for (int kt = 0; kt < 2; ++kt) { f32x4 a = {0.f, 0.f, 0.f, 0.f}; a = MFMA16(kf[kt * 2], qf[nt][0], a); a = MFMA16(kf[kt * 2 + 1], qf[nt][1], a); S[nt][kt] = a; }
#pragma unroll
            for (int kt = 0; kt < 2; ++kt)
#pragma unroll
                for (int dt = 0; dt < 4; ++dt) vt[kt][dt] = MFMA16(vf[kt * 2 + (dt >> 1)], isel[dt & 1], ((f32x4){0.f, 0.f, 0.f, 0.f}));
            if (it < 9 && variant != 1) { const int g2 = it + 1 >= 5 ? 1 : 0, ch2 = it + 1 - 5 * g2; int cls2, qi2; attn_group(br, 2 * wave + g2, p0, cls2, qi2);
                attn_load(Zh, s0, sh, n, cls2, qi2 - 64 + 32 * ch2, lane, kf, vf); }
            bf16x8 vtp[4];
#pragma unroll
            for (int dt = 0; dt < 4; ++dt) { u32x4 vw; vw.x = cvt_pk_bf16(vt[0][dt][0], vt[0][dt][1]); vw.y = cvt_pk_bf16(vt[0][dt][2], vt[0][dt][3]); vw.z = cvt_pk_bf16(vt[1][dt][0], vt[1][dt][1]); vw.w = cvt_pk_bf16(vt[1][dt][2], vt[1][dt][3]);
                vtp[dt] = __builtin_bit_cast(bf16x8, vw); }
            const bool seqedge = (kb < 0 || kb + 32 > n);
#pragma unroll
            for (int nt = 0; nt < 2; ++nt) {
                float sv[8]; float mx = -1e30f;
                const int relb = -64 + 32 * ch + quad * 4 - fr - 16 * nt;
                if (seqedge) {
#pragma unroll
                    for (int kt = 0; kt < 2; ++kt)
#pragma unroll
                        for (int j = 0; j < 4; ++j) { const int rel = relb + kt * 16 + j, key = qi + 16 * nt + fr + rel, ar = rel < 0 ? -rel : rel;
                            const bool ok = (ar <= 64) && ((unsigned)key < (unsigned)n); const float s = ok ? fmaf(nbc, (float)ar, S[nt][kt][j]) : -3.0e38f; sv[kt * 4 + j] = s; mx = fmaxf(mx, s); }
                } else { const float frel = (float)relb; const int dl = fr + 16 * nt - quad * 4;
                    if (ch == 0) {
#pragma unroll
                        for (int kt = 0; kt < 2; ++kt)
#pragma unroll
                            for (int j = 0; j < 4; ++j) { float s = fmaf(nbc, fabsf(frel + (float)(kt * 16 + j)), S[nt][kt][j]); s = (kt * 16 + j >= dl) ? s : -3.0e38f; sv[kt * 4 + j] = s; mx = fmaxf(mx, s); }
                    } else if (ch == 4) {
#pragma unroll
                        for (int kt = 0; kt < 2; ++kt)
#pragma unroll
                            for (int j = 0; j < 4; ++j) { float s = fmaf(nbc, fabsf(frel + (float)(kt * 16 + j)), S[nt][kt][j]); s = (kt * 16 + j <= dl) ? s : -3.0e38f; sv[kt * 4 + j] = s; mx = fmaxf(mx, s); }
                    } else {
#pragma unroll
                        for (int kt = 0; kt < 2; ++kt)
#pragma unroll
                            for (int j = 0; j < 4; ++j) { const float s = fmaf(nbc, fabsf(frel + (float)(kt * 16 + j)), S[nt][kt][j]); sv[kt * 4 + j] = s; mx = fmaxf(mx, s); }
                    }
                }
                if (!__all(mx - m[nt] <= 8.0f)) {
                    mx = quad_max(mx);
                    const float mn = fmaxf(m[nt], mx), alpha = __builtin_amdgcn_exp2f(m[nt] - mn);
                    l[nt] *= alpha; m[nt] = mn;
#pragma unroll
                    for (int dt = 0; dt < 4; ++dt) O[nt][dt] = O[nt][dt] * alpha;
                }
                float ps = 0.f; float pv[8]; const float mcur = m[nt];
#pragma unroll
                for (int e = 0; e < 8; ++e) { pv[e] = __builtin_amdgcn_exp2f(sv[e] - mcur); ps += pv[e]; }
                l[nt] += ps;
                u32x4 pw; pw.x = cvt_pk_bf16(pv[0], pv[1]); pw.y = cvt_pk_bf16(pv[2], pv[3]); pw.z = cvt_pk_bf16(pv[4], pv[5]); pw.w = cvt_pk_bf16(pv[6], pv[7]);
                const bf16x8 pf = __builtin_bit_cast(bf16x8, pw);
#pragma unroll
                for (int dt = 0; dt < 4; ++dt) O[nt][dt] = MFMA16(vtp[dt], pf, O[nt][dt]);
            }
            if (ch == 4) {
#pragma unroll
                for (int nt = 0; nt < 2; ++nt) {
                    const float lt = quad_sum(l[nt]);
                    if (br < 2) { if (quad == 0) { ml[tl[nt]] = m[nt]; ll[tl[nt]] = lt; }
#pragma unroll
                        for (int dt = 0; dt < 4; ++dt) *(LAS f32x4*)(Ol + tl[nt] * 68 + dt * 16 + quad * 4) = O[nt][dt];
                    } else { const float inv = 1.0f / lt; u32x2 oo[4];
#pragma unroll
                        for (int dt = 0; dt < 4; ++dt) { oo[dt].x = cvt_pk_bf16(O[nt][dt][0] * inv, O[nt][dt][1] * inv); oo[dt].y = cvt_pk_bf16(O[nt][dt][2] * inv, O[nt][dt][3] * inv); }
#pragma unroll
                        for (int dp = 0; dp < 2; ++dp) {
                            const auto rx = __builtin_amdgcn_permlane16_swap(oo[2 * dp].x, oo[2 * dp + 1].x, false, false), ry = __builtin_amdgcn_permlane16_swap(oo[2 * dp].y, oo[2 * dp + 1].y, false, false);
                            u32x4 w; w.x = rx[0]; w.y = ry[0]; w.z = rx[1]; w.w = ry[1];
                            const int col = (quad & 1) ? (2 * dp + 1) * 16 + (quad - 1) * 4 : (2 * dp) * 16 + quad * 4;
                            *(u32x4*)(OC + (size_t)tq[nt] * DM + 512 + h * 64 + col) = w; } }
                }
            }
        }
        lds_barrier();
    }
}
__global__ void __launch_bounds__(NTHREADS, 2) hymba_fwd(Params p) {
    extern __shared__ __attribute__((aligned(16))) unsigned char smem[];
    LAS unsigned char* lds = (LAS unsigned char*)smem;
    cg::grid_group grid = cg::this_grid();
    volatile LAS unsigned* bst = (volatile LAS unsigned*)(lds + LDS_BYTES - 64);
    if (threadIdx.x < 2) bst[threadIdx.x] = 0u;
    __syncthreads();
    const XcdBarrier xbar = xcd_barrier_post((unsigned*)(p.ws + WS_BAR), bst);
    unsigned char* ws = p.ws;
    float* ssq = (float*)(ws + WS_SSQ);
    bf16_t* actA = (bf16_t*)(ws + WS_ACTA); bf16_t* big = (bf16_t*)(ws + WS_BIG);
    bf16_t* hb0 = (bf16_t*)p.out; bf16_t* hb1 = hb0 + (size_t)MTOK * DM;
    pg8::StaticOrder S;
    for (int rep = 0; rep < PROBE_PRO; ++rep) prologue(p, lds);
    grid.sync();
    { pg8::Gemm g{actA, (const bf16_t*)(ws + WS_W1GU), MTOK, NGU, DM}; S.init(MTOK, NGU, gridDim.x, blockIdx.x); EpiSwiglu E{big, ssq};
      pg8::gemm_phase<EpiSwiglu, pg8::StaticOrder, true, true>(lds, g, S, E);
      if (PROBE_P1 == 2) { xcd_barrier(xbar); pg8::gemm_phase<EpiSwiglu, pg8::StaticOrder, true, true>(lds, g, S, E); }
      { const int nwg = (MTOK / 256) * (NGU / 256), G = (int)gridDim.x, rem = nwg % G, c = (int)blockIdx.x; const int tid = ltid();
        if (c >= rem) deferred_weights(p, lds, (c - rem) * 8 + (tid >> 6), (G - rem) * 8); } }
    xcd_barrier(xbar);
    { pg8::Gemm g{big, (const bf16_t*)(ws + WS_W1D), MTOK, DM, DFF}; S.init(MTOK, DM, gridDim.x, blockIdx.x); EpiResid<true> E{nullptr, nullptr, 0, actA, hb0, ssq + MTOK, 0.5f};
      pg8::gemm_phase<EpiResid<true>, pg8::StaticOrder, true, true>(lds, g, S, E); }
    xcd_barrier(xbar);
    { pg8::Gemm g{hb0, (const bf16_t*)(ws + WS_WIN), MTOK, 3072, DM}; S.init(MTOK, 3072, gridDim.x, blockIdx.x); EpiZ E{big, ssq + MTOK};
      pg8::gemm_phase<EpiZ, pg8::StaticOrder, true, true>(lds, g, S, E); }
    for (int it = blockIdx.x; it < MTOK / 64; it += gridDim.x) lr_gemm_item(hb0, (const bf16_t*)(ws + WS_WIN) + (size_t)3072 * DM, ssq + MTOK, big, lds, it);
    xcd_barrier(xbar);
    for (int u = blockIdx.x; u < 160 * 8 * PROBE_ATT; u += gridDim.x) attn_unit(p, lds, (u % 1280) >> 3, u & 7, (PROBE_ATT == 2 && u < 1280) ? PROBE_VAR : 0);
    for (int u = blockIdx.x; u < NCHUNK * 4 * PROBE_G1; u += gridDim.x) gla_g1_unit(p, lds, (u % (NCHUNK * 4)) >> 2, u & 3, u + gridDim.x);
    xcd_barrier(xbar);
    gla_g2(p);
    xcd_barrier(xbar);
    for (int u = blockIdx.x; u < NCHUNK * 4 * PROBE_G3; u += gridDim.x) gla_g3_unit(p, lds, (u % (NCHUNK * 4)) >> 2, u & 3, u + gridDim.x);
    xcd_barrier(xbar);
    { pg8::Gemm g{actA, (const bf16_t*)(ws + WS_WOUT), MTOK, DM, DM}; S.init(MTOK, DM, gridDim.x, blockIdx.x); EpiResid<true> E{nullptr, nullptr, 0, hb0, hb1, ssq + 2 * MTOK, 1.0f};
      pg8::gemm_phase<EpiResid<true>, pg8::StaticOrder, true, true>(lds, g, S, E); }
    xcd_barrier(xbar);
    { pg8::Gemm g{hb1, (const bf16_t*)(ws + WS_W2GU), MTOK, NGU, DM}; S.init(MTOK, NGU, gridDim.x, blockIdx.x); EpiSwiglu E{big, ssq + 2 * MTOK};
      pg8::gemm_phase<EpiSwiglu, pg8::StaticOrder, true, true>(lds, g, S, E); }
    xcd_barrier(xbar);
    { pg8::Gemm g{big, (const bf16_t*)(ws + WS_W2D), MTOK, DM, DFF}; S.init(MTOK, DM, gridDim.x, blockIdx.x); EpiResid<true> E{nullptr, nullptr, 0, hb1, actA, ssq + 3 * MTOK, 0.5f};
      pg8::gemm_phase<EpiResid<true>, pg8::StaticOrder, true, true>(lds, g, S, E); }
    xcd_barrier(xbar);
    { const int tid = ltid(), lane = tid & 63, wave = tid >> 6; const int gw = blockIdx.x * 8 + wave, NGW = gridDim.x * 8; const float* gf = p.in[18];
      f32x4 gv[4];
#pragma unroll
      for (int j = 0; j < 4; ++j) gv[j] = ((const f32x4*)gf)[2 * lane + (j & 1) + 128 * (j >> 1)];
      for (int row = gw; row < MTOK; row += 2 * NGW) {
          const int row2 = row + NGW < MTOK ? row + NGW : row;
          const u32x4 a0 = ((const u32x4*)(actA + (size_t)row * DM))[lane], a1 = ((const u32x4*)(actA + (size_t)row * DM))[lane + 64];
          const u32x4 b0 = ((const u32x4*)(actA + (size_t)row2 * DM))[lane], b1 = ((const u32x4*)(actA + (size_t)row2 * DM))[lane + 64];
          const float rs = rsqrtf(ssq[3 * MTOK + row] * (1.0f / DM) + EPS), rs2 = rsqrtf(ssq[3 * MTOK + row2] * (1.0f / DM) + EPS);
#define P10_OUT(rw, scale, q0, q1) do { f32x4* o = (f32x4*)(p.out + (size_t)(rw) * DM); \
          o[2 * lane] = (f32x4){__uint_as_float(q0.x << 16), __uint_as_float(q0.x & 0xffff0000u), __uint_as_float(q0.y << 16), __uint_as_float(q0.y & 0xffff0000u)} * (scale) * gv[0]; \
          o[2 * lane + 1] = (f32x4){__uint_as_float(q0.z << 16), __uint_as_float(q0.z & 0xffff0000u), __uint_as_float(q0.w << 16), __uint_as_float(q0.w & 0xffff0000u)} * (scale) * gv[1]; \
          o[128 + 2 * lane] = (f32x4){__uint_as_float(q1.x << 16), __uint_as_float(q1.x & 0xffff0000u), __uint_as_float(q1.y << 16), __uint_as_float(q1.y & 0xffff0000u)} * (scale) * gv[2]; \
          o[128 + 2 * lane + 1] = (f32x4){__uint_as_float(q1.z << 16), __uint_as_float(q1.z & 0xffff0000u), __uint_as_float(q1.w << 16), __uint_as_float(q1.w & 0xffff0000u)} * (scale) * gv[3]; } while (0)
          P10_OUT(row, rs, a0, a1);
          if (row2 != row) P10_OUT(row2, rs2, b0, b1);
#undef P10_OUT
      } }
}

extern "C" void kernel_launch(void* const* d_in, const int* in_sizes, int n_in, void* d_out, int out_size, void* d_ws, size_t ws_size, hipStream_t stream) {
    static int grid = 0;
    if (grid == 0) {
        if (n_in != 19 || out_size != MTOK * DM || ws_size < WS_END) { fprintf(stderr, "kernel_launch: unexpected shapes (n_in %d out %d ws %zu)\n", n_in, out_size, ws_size); grid = -1; return; }
        int dev = 0, cus = 0, per_cu = 0;
        hipGetDevice(&dev); hipDeviceGetAttribute(&cus, hipDeviceAttributeMultiprocessorCount, dev);
        if (hipFuncSetAttribute((const void*)hymba_fwd, hipFuncAttributeMaxDynamicSharedMemorySize, LDS_BYTES) != hipSuccess) { fprintf(stderr, "kernel_launch: hipFuncSetAttribute failed\n"); grid = -1; return; }
        if (hipOccupancyMaxActiveBlocksPerMultiprocessor(&per_cu, (const void*)hymba_fwd, NTHREADS, LDS_BYTES) != hipSuccess || per_cu < 1) { fprintf(stderr, "kernel_launch: occupancy query gave %d\n", per_cu); per_cu = 1; }
        (void)hipGetLastError();
        grid = cus * 1;
    }
    if (grid < 0) return;
    if (hipMemsetAsync((char*)d_ws + WS_BAR, 0, XCD_BAR_WORDS * 4, stream) != hipSuccess) { fprintf(stderr, "kernel_launch: memset of the barrier words failed\n"); return; }
    Params p{};
    for (int i = 0; i < 19; ++i) p.in[i] = (const float*)d_in[i];
    p.out = (float*)d_out; p.ws = (unsigned char*)d_ws;
    void* args[] = {&p};
    hipError_t e = hipLaunchCooperativeKernel((const void*)hymba_fwd, dim3(grid), dim3(NTHREADS), args, LDS_BYTES, stream);
    if (e != hipSuccess) fprintf(stderr, "cooperative launch failed: %s (grid %d)\n", hipGetErrorString(e), grid);
}
```

```cpp
#include <hip/hip_runtime.h>
#include <hip/hip_cooperative_groups.h>
#include <cstdio>
#include <cstdint>
namespace cg = cooperative_groups;
#define PROBE_ATT 1
#define PROBE_G1 1
#define PROBE_G3 1
#define PROBE_PRO 1
#define PROBE_VAR 1
#define PROBE_P1 1
#define ATT_TOUCH 0
#define GLA_TOUCH 0
namespace pg8 {
#define PG8_LAS __attribute__((address_space(3)))
typedef unsigned short bf16_t;
typedef short bf16x8 __attribute__((ext_vector_type(8)));
typedef float f32x4 __attribute__((ext_vector_type(4)));
typedef unsigned u32x4 __attribute__((ext_vector_type(4)));
constexpr int BM = 256, BK = 64, HALF = 128, HTB = HALF * BK * 2  , STAGE_BYTES = 8 * HTB, NXCD = 8, WGM = 8;

__host__ __device__ __forceinline__ int lds_byte(int r, int c) { const int st = (r >> 4) * 2 + (c >> 5), rr = r & 15, cc = c & 31, ob = rr * 64 + cc * 2; return st * 1024 + (ob ^ (((ob >> 9) & 1) << 5)); }
__host__ __device__ __forceinline__ void stage_rc(int b, int& R, int& C) { const int st = b / 1024, sb = b % 1024, swz = sb ^ (((sb >> 9) & 1) << 5); R = (st >> 1) * 16 + swz / 64; C = (st & 1) * 32 + (swz % 64) / 2; }
__host__ __device__ __forceinline__ int perm32(int rho) { const int n = rho >> 4, i = rho & 15; return 8 * (i >> 2) + 4 * n + (i & 3); }

struct Unit { int pm, pn; };
struct Gemm { const bf16_t* A; const bf16_t* Bt; int M, N, K; };

struct StaticOrder {
    int nM, nN, nwg, G, c;
    __host__ __device__ void init(int M, int N, int G_, int c_) { nM = M / BM; nN = N / BM; nwg = nM * nN; G = G_; c = c_; }
    __host__ __device__ bool next(int i, Unit& u) const {
        const long L = (long)i * G + c; if (L >= nwg) return false;
        int wgid = (int)L; { const int q = nwg / NXCD, r = nwg % NXCD, xcd = wgid % NXCD, off = wgid / NXCD; wgid = (xcd < r ? xcd * (q + 1) : r * (q + 1) + (xcd - r) * q) + off; }
        const int nig = WGM * nN, gid = wgid / nig, fm = gid * WGM, gsz = (nM - fm) < WGM ? (nM - fm) : WGM;
        u.pm = fm + ((wgid % nig) % gsz); u.pn = (wgid % nig) / gsz; return true;
    }
    __device__ __forceinline__ void a_ready(const Unit&) const {}
    __device__ __forceinline__ void done(const Unit&) const {}
};
typedef __bf16 bf16x2_hw __attribute__((ext_vector_type(2)));
__device__ __forceinline__ unsigned cvt_pk_bf16(float lo, float hi) { bf16x2_hw v; v[0] = (__bf16)lo; v[1] = (__bf16)hi; return __builtin_bit_cast(unsigned, v); }
template <class Epi, class Sched, bool ALIGN_EPI = false, bool SP2 = false>
__device__ __forceinline__ void gemm_phase(PG8_LAS unsigned char* lds, const Gemm g, const Sched& S, const Epi& E) {
    const int tid = threadIdx.x, wid = __builtin_amdgcn_readfirstlane(tid >> 6), lane = tid & 63, wr = wid >> 2, wc = wid & 3, fr = lane & 15, fq = lane >> 4;
    const int K = g.K, nt = K / BK;
    unsigned voffA[2], voffB[2];
#pragma unroll
    for (int i = 0; i < 2; ++i) { int R, C; stage_rc(tid * 16 + i * 8192, R, C); const int Rb = Epi::PERM ? ((R & ~31) + perm32(R & 31)) : R;
        voffA[i] = (unsigned)(R * K + C) * 2u; voffB[i] = (unsigned)(Rb * K + C) * 2u; }
    const size_t kstep = (size_t)(BK * 2);
    const size_t hstep = (size_t)HALF * K * 2;
    const size_t tstep = 2 * hstep;
    const unsigned ldsw = (unsigned)wid * 1024u;
    const int aoff = lds_byte(wr * 64 + fr, fq * 8), boff = lds_byte(wc * 32 + fr, fq * 8);
#define PG8_SA(b, h) (((b) * 2 + (h)) * HTB)
#define PG8_SB(b, h) ((4 + (b) * 2 + (h)) * HTB)
#define PG8_STAGE(bufoff, gbase, voff) do { _Pragma("unroll") for (int _i = 0; _i < 2; ++_i) \
        __builtin_amdgcn_global_load_lds((const unsigned*)((const char*)(gbase) + (voff)[_i]), (PG8_LAS unsigned*)(lds + (bufoff) + ldsw + _i * 8192), 16, 0, 0); } while (0)
#define PG8_LDA(dst, b, h) do { _Pragma("unroll") for (int m = 0; m < 4; ++m) _Pragma("unroll") for (int k = 0; k < 2; ++k) dst[m][k] = *(const PG8_LAS bf16x8*)(lds + PG8_SA(b, h) + aoff + m * 2048 + k * 1024); } while (0)
#define PG8_LDB(dst, b, h) do { _Pragma("unroll") for (int n = 0; n < 2; ++n) _Pragma("unroll") for (int k = 0; k < 2; ++k) dst[n][k] = *(const PG8_LAS bf16x8*)(lds + PG8_SB(b, h) + boff + n * 2048 + k * 1024); } while (0)
#define PG8_MMA(ai, bj, At, Bt) do { __builtin_amdgcn_s_setprio(1); _Pragma("unroll") for (int m = 0; m < 4; ++m) _Pragma("unroll") for (int n = 0; n < 2; ++n) _Pragma("unroll") for (int k = 0; k < 2; ++k) \
        acc[ai][bj][m][n] = __builtin_amdgcn_mfma_f32_16x16x32_bf16(Bt[n][k], At[m][k], acc[ai][bj][m][n], 0, 0, 0); __builtin_amdgcn_s_setprio(0); } while (0)
#define PG8_WAIT_V(n) asm volatile("s_waitcnt vmcnt(" #n ")" ::: "memory")
#define PG8_WAIT_L(n) asm volatile("s_waitcnt lgkmcnt(" #n ")" ::: "memory")
#define PG8_BAR __builtin_amdgcn_s_barrier()
#define PG8_SCHED __builtin_amdgcn_sched_barrier(0)
    Unit cur, nxt; int ui = 0;
    if (!S.next(0, cur)) return;
    f32x4 acc[2][2][4][2];
#pragma unroll
    for (int a = 0; a < 2; ++a)
#pragma unroll
        for (int b = 0; b < 2; ++b)
#pragma unroll
            for (int m = 0; m < 4; ++m)
#pragma unroll
                for (int n = 0; n < 2; ++n) acc[a][b][m][n] = (f32x4){0.f, 0.f, 0.f, 0.f};
    bf16x8 At[4][2], B0[2][2], B1[2][2];
    const char* cA = (const char*)g.A + (size_t)cur.pm * tstep; const char* cB = (const char*)g.Bt + (size_t)cur.pn * tstep;
    S.a_ready(cur);
    if constexpr (SP2) {
        PG8_STAGE(PG8_SB(0, 0), cB, voffB); PG8_STAGE(PG8_SB(0, 1), cB + hstep, voffB); PG8_STAGE(PG8_SA(0, 0), cA, voffA); PG8_STAGE(PG8_SA(0, 1), cA + hstep, voffA);
        if (wr == 1) PG8_BAR;
        PG8_WAIT_V(2); PG8_BAR;
        PG8_STAGE(PG8_SB(1, 0), cB + kstep, voffB); PG8_STAGE(PG8_SA(1, 0), cA + kstep, voffA); PG8_STAGE(PG8_SB(1, 1), cB + hstep + kstep, voffB);
        PG8_WAIT_V(6); PG8_BAR;
    } else {
        PG8_STAGE(PG8_SB(0, 0), cB, voffB); PG8_STAGE(PG8_SA(0, 0), cA, voffA); PG8_STAGE(PG8_SB(0, 1), cB + hstep, voffB); PG8_STAGE(PG8_SA(0, 1), cA + hstep, voffA);
        if (wr == 1) PG8_BAR;
        PG8_WAIT_V(4); PG8_BAR;
        PG8_STAGE(PG8_SB(1, 0), cB + kstep, voffB); PG8_STAGE(PG8_SA(1, 0), cA + kstep, voffA); PG8_STAGE(PG8_SB(1, 1), cB + hstep + kstep, voffB);
        PG8_WAIT_V(6); PG8_BAR;
    }
    for (;;) {
        const bool has_next = S.next(ui + 1, nxt);
        const char* nA = has_next ? (const char*)g.A + (size_t)nxt.pm * tstep : cA; const char* nB = has_next ? (const char*)g.Bt + (size_t)nxt.pn * tstep : cB;
        for (int t = 0; t < nt; t += 2) {
            const bool last = (t == nt - 2);
            const char* a1 = cA + (size_t)(t + 1) * kstep;
            const char* a2 = last ? nA : cA + (size_t)(t + 2) * kstep; const char* b2 = last ? nB : cB + (size_t)(t + 2) * kstep;
            const char* a3 = a2 + kstep; const char* b3 = b2 + kstep;
            if (last && has_next) S.a_ready(nxt);
            if constexpr (SP2) {
            PG8_LDB(B0, 0, 0); PG8_LDB(B1, 0, 1); PG8_SCHED; PG8_LDA(At, 0, 0); PG8_STAGE(PG8_SA(1, 1), a1 + hstep, voffA);
            PG8_WAIT_V(8); PG8_WAIT_L(0); PG8_BAR; PG8_MMA(0, 0, At, B0); PG8_MMA(0, 1, At, B1); PG8_BAR; PG8_SCHED;
            PG8_LDA(At, 0, 1); PG8_STAGE(PG8_SB(0, 0), b2, voffB); PG8_STAGE(PG8_SB(0, 1), b2 + hstep, voffB); PG8_STAGE(PG8_SA(0, 0), a2, voffA);
            PG8_WAIT_V(8); PG8_WAIT_L(0); PG8_BAR; PG8_MMA(1, 0, At, B0); PG8_MMA(1, 1, At, B1); PG8_BAR; PG8_SCHED;
            PG8_LDB(B0, 1, 0); PG8_LDB(B1, 1, 1); PG8_SCHED; PG8_LDA(At, 1, 0); PG8_STAGE(PG8_SA(0, 1), a2 + hstep, voffA);
            PG8_WAIT_V(8); PG8_WAIT_L(0); PG8_BAR; PG8_MMA(0, 0, At, B0); PG8_MMA(0, 1, At, B1); PG8_BAR; PG8_SCHED;
            PG8_LDA(At, 1, 1); PG8_STAGE(PG8_SB(1, 0), b3, voffB); PG8_STAGE(PG8_SB(1, 1), b3 + hstep, voffB); PG8_STAGE(PG8_SA(1, 0), a3, voffA);
            PG8_WAIT_V(8); PG8_WAIT_L(0); PG8_BAR; PG8_MMA(1, 0, At, B0); PG8_MMA(1, 1, At, B1); PG8_BAR; PG8_SCHED;
            } else {
            PG8_LDB(B0, 0, 0); PG8_SCHED; PG8_LDA(At, 0, 0); PG8_STAGE(PG8_SA(1, 1), a1 + hstep, voffA);
            PG8_WAIT_L(8); PG8_BAR; PG8_WAIT_L(0); PG8_MMA(0, 0, At, B0); PG8_BAR; PG8_SCHED;
            PG8_LDB(B1, 0, 1); PG8_STAGE(PG8_SB(0, 0), b2, voffB);
            PG8_BAR; PG8_WAIT_L(0); PG8_MMA(0, 1, At, B1); PG8_BAR;
            PG8_LDA(At, 0, 1); PG8_STAGE(PG8_SA(0, 0), a2, voffA);
            PG8_BAR; PG8_WAIT_L(0); PG8_MMA(1, 0, At, B0); PG8_BAR; PG8_SCHED;
            PG8_STAGE(PG8_SB(0, 1), b2 + hstep, voffB);
            PG8_WAIT_V(6); PG8_BAR; PG8_MMA(1, 1, At, B1); PG8_BAR;
            PG8_LDB(B0, 1, 0); PG8_SCHED; PG8_LDA(At, 1, 0); PG8_STAGE(PG8_SA(0, 1), a2 + hstep, voffA);
            PG8_WAIT_L(8); PG8_BAR; PG8_WAIT_L(0); PG8_MMA(0, 0, At, B0); PG8_BAR; PG8_SCHED;
            PG8_LDB(B1, 1, 1); PG8_STAGE(PG8_SB(1, 0), b3, voffB);
            PG8_BAR; PG8_WAIT_L(0); PG8_MMA(0, 1, At, B1); PG8_BAR;
            PG8_LDA(At, 1, 1); PG8_STAGE(PG8_SA(1, 0), a3, voffA);
            PG8_BAR; PG8_WAIT_L(0); PG8_MMA(1, 0, At, B0); PG8_BAR; PG8_SCHED;
            PG8_STAGE(PG8_SB(1, 1), b3 + hstep, voffB);
            PG8_WAIT_V(6); PG8_BAR; PG8_MMA(1, 1, At, B1); PG8_BAR;
            }
        }
        if constexpr (ALIGN_EPI) { if (wr == 0) PG8_BAR; }
        if constexpr (!Epi::AFTER_DRAIN) { E(acc, cur, wr, wc, fr, fq); S.done(cur); }
        if (!has_next) break;
#pragma unroll
        for (int a = 0; a < 2; ++a)
#pragma unroll
            for (int b = 0; b < 2; ++b)
#pragma unroll
                for (int m = 0; m < 4; ++m)
#pragma unroll
                    for (int n = 0; n < 2; ++n) acc[a][b][m][n] = (f32x4){0.f, 0.f, 0.f, 0.f};
        cur = nxt; cA = nA; cB = nB; ++ui;
        if constexpr (ALIGN_EPI) { if (wr == 1) PG8_BAR; }
    }
    PG8_WAIT_V(0);
    if constexpr (!ALIGN_EPI) { if (wr == 0) PG8_BAR; }
    PG8_BAR;
    if constexpr (Epi::AFTER_DRAIN) { E.fused(acc, cur, wr, wc, fr, fq, lds, wid, lane); S.done(cur); }
#undef PG8_SA
#undef PG8_SB
#undef PG8_STAGE
#undef PG8_LDA
#undef PG8_LDB
#undef PG8_MMA
#undef PG8_WAIT_V
#undef PG8_WAIT_L
#undef PG8_BAR
#undef PG8_SCHED
}
}
using pg8::bf16_t; using pg8::bf16x8; using pg8::f32x4; using pg8::u32x4; using pg8::Unit; using pg8::cvt_pk_bf16;
#define LAS __attribute__((address_space(3)))
typedef unsigned u32x2 __attribute__((ext_vector_type(2)));
typedef short s16x4 __attribute__((ext_vector_type(4)));

constexpr int MTOK = 81920, MPROMPT = 65536, DM = 1024, DFF = 2816, NGU = 5632, NZC = 3104  , NZ = 3136  , NZP = 3328;
constexpr int ZQ = 0, ZK = 256, ZV = 512, ZR = 1024, ZAQ = 1536, ZAK = 2048, ZAV = 2560, ZLF = 3072, ZLB = 3088;
constexpr int NCHUNK = 1280;
constexpr float EPS = 1e-6f, LOG2E = 1.4426950408889634f;
constexpr size_t MiB = 1u << 20;
constexpr size_t WS_SSQ = 0, WS_DEC = 2 * MiB, WS_W1GU = 5 * MiB, WS_W1D = 16 * MiB, WS_W2GU = 22 * MiB, WS_W2D = 33 * MiB, WS_WIN = 39 * MiB, WS_WOUT = 46 * MiB,
                 WS_ACTA = 48 * MiB, WS_ST = 208 * MiB, WS_BIG = 368 * MiB, WS_DUMMY = 860 * MiB, WS_BAR = 862 * MiB, WS_END = 863 * MiB;
constexpr int LDS_BYTES = 147456;
constexpr int NTHREADS = 512;

struct Params { const float* in[19]; float* out; unsigned char* ws; };

__device__ __forceinline__ int ltid() { int t = threadIdx.x; asm volatile("" : "+v"(t)); return t; }
__device__ __forceinline__ float bf2f(unsigned short b) { return __uint_as_float((unsigned)b << 16); }
__device__ __forceinline__ unsigned short f2bf(float f) { unsigned u = __float_as_uint(f); return (unsigned short)((u + 0x7fffu + ((u >> 16) & 1u)) >> 16); }
__device__ __forceinline__ float wave_sum(float v) {
#pragma unroll
    for (int o = 1; o < 64; o <<= 1) v += __shfl_xor(v, o);
    return v;
}
__device__ __forceinline__ float quad_max(float x) {
    auto a = __builtin_amdgcn_permlane16_swap(__float_as_uint(x), __float_as_uint(x), false, false); x = fmaxf(__uint_as_float(a[0]), __uint_as_float(a[1]));
    auto b = __builtin_amdgcn_permlane32_swap(__float_as_uint(x), __float_as_uint(x), false, false); return fmaxf(__uint_as_float(b[0]), __uint_as_float(b[1]));
}
__device__ __forceinline__ float quad_sum(float x) {
    auto a = __builtin_amdgcn_permlane16_swap(__float_as_uint(x), __float_as_uint(x), false, false); x = __uint_as_float(a[0]) + __uint_as_float(a[1]);
    auto b = __builtin_amdgcn_permlane32_swap(__float_as_uint(x), __float_as_uint(x), false, false); return __uint_as_float(b[0]) + __uint_as_float(b[1]);
}
__device__ __forceinline__ void lds_barrier() { asm volatile("s_waitcnt lgkmcnt(0)" ::: "memory"); __builtin_amdgcn_s_barrier(); asm volatile("" ::: "memory"); }
#define LDS_WAIT() asm volatile("s_waitcnt lgkmcnt(0)" ::: "memory")

__device__ __forceinline__ void transpose_item(const float* W, int K, int N, bf16_t* WT, int mode, const float* gk, LAS float* scr, int item, int lane) {
    const int nblk = N / 32, kb = item / nblk, nb = item % nblk, k0 = 64 * kb, n0 = 32 * nb;
#pragma unroll 8
    for (int i = 0; i < 32; ++i) { const int kk = 2 * i + (lane >> 5); const float g = gk ? gk[k0 + kk] : 1.0f; scr[kk * 33 + (lane & 31)] = W[(size_t)(k0 + kk) * N + n0 + (lane & 31)] * g; }
    LDS_WAIT(); asm volatile("" ::: "memory");
    const int c = lane & 7;
#pragma unroll
    for (int j = 0; j < 4; ++j) {
        const int n = (lane >> 3) + 8 * j, ns = n0 + n; int drow = ns; float rs = 1.0f;
        if (mode == 1) drow = (ns >> 2) * 8 + (ns & 3);
        else if (mode == 2) drow = (ns >> 2) * 8 + 4 + (ns & 3);
        else if (mode == 3) { drow = ns < 1536 ? ns : (ns < 1568 ? ns + 1536 : ns - 32); if (ns < 256) rs = 0.125f; else if (ns >= 1568 && ns < 2080) rs = 0.125f * LOG2E; }
        const LAS float* s = scr + (8 * c) * 33 + n;
        u32x4 o; o.x = cvt_pk_bf16(s[0 * 33] * rs, s[1 * 33] * rs); o.y = cvt_pk_bf16(s[2 * 33] * rs, s[3 * 33] * rs); o.z = cvt_pk_bf16(s[4 * 33] * rs, s[5 * 33] * rs); o.w = cvt_pk_bf16(s[6 * 33] * rs, s[7 * 33] * rs);
        *(u32x4*)(WT + (size_t)drow * K + k0 + 8 * c) = o;
    }
    LDS_WAIT(); asm volatile("" ::: "memory");
}

__device__ __forceinline__ void prologue(const Params& p, LAS unsigned char* lds) {
    const int tid = ltid(), lane = tid & 63, wave = tid >> 6;
    const int gw = blockIdx.x * 8 + wave, NGW = gridDim.x * 8;
    LAS float* scr = (LAS float*)(lds + wave * 8704);
    unsigned char* ws = p.ws;
    constexpr int I_GU = (DM / 64) * (DFF / 32), I_D = (DFF / 64) * (DM / 32);
    constexpr int NITEMS = 2 * I_GU + I_D;
    for (int it = gw; it < NITEMS; it += NGW) {
        int r = it;
        if (r < I_GU) { transpose_item(p.in[3], DM, DFF, (bf16_t*)(ws + WS_W1GU), 1, p.in[2], scr, r, lane); continue; } r -= I_GU;
        if (r < I_GU) { transpose_item(p.in[4], DM, DFF, (bf16_t*)(ws + WS_W1GU), 2, p.in[2], scr, r, lane); continue; } r -= I_GU;
        transpose_item(p.in[5], DFF, DM, (bf16_t*)(ws + WS_W1D), 0, nullptr, scr, r, lane);
    }
    float* ssq = (float*)(ws + WS_SSQ); bf16_t* xb = (bf16_t*)(ws + WS_ACTA);
    for (int row = gw; row < MTOK; row += 2 * NGW) {
        const int row2 = row + NGW; const bool has2 = row2 < MTOK;
        const float* xr = row < MPROMPT ? p.in[0] + (size_t)row * DM : p.in[1] + (size_t)(row - MPROMPT) * DM;
        const float* xr2 = !has2 ? xr : (row2 < MPROMPT ? p.in[0] + (size_t)row2 * DM : p.in[1] + (size_t)(row2 - MPROMPT) * DM);
        f32x4 v[4], v2[4]; float s = 0.f, s2 = 0.f;
#pragma unroll
        for (int j = 0; j < 4; ++j) { v[j] = ((const f32x4*)xr)[lane + 64 * j]; v2[j] = ((const f32x4*)xr2)[lane + 64 * j]; }
#pragma unroll
        for (int j = 0; j < 4; ++j) { s += (v[j].x * v[j].x + v[j].y * v[j].y) + (v[j].z * v[j].z + v[j].w * v[j].w); s2 += (v2[j].x * v2[j].x + v2[j].y * v2[j].y) + (v2[j].z * v2[j].z + v2[j].w * v2[j].w); }
        s = wave_sum(s); s2 = wave_sum(s2);
#pragma unroll
        for (int j = 0; j < 4; ++j) { u32x2 o; o.x = cvt_pk_bf16(v[j].x, v[j].y); o.y = cvt_pk_bf16(v[j].z, v[j].w); ((u32x2*)(xb + (size_t)row * DM))[lane + 64 * j] = o; }
        if (lane == 0) ssq[row] = s;
        if (has2) {
#pragma unroll
            for (int j = 0; j < 4; ++j) { u32x2 o; o.x = cvt_pk_bf16(v2[j].x, v2[j].y); o.y = cvt_pk_bf16(v2[j].z, v2[j].w); ((u32x2*)(xb + (size_t)row2 * DM))[lane + 64 * j] = o; }
            if (lane == 0) ssq[row2] = s2; }
    }
    const int gt = blockIdx.x * NTHREADS + tid, NGT = gridDim.x * NTHREADS;
    for (int i = gt; i < 3 * MTOK / 4; i += NGT) ((f32x4*)(ssq + MTOK))[i] = (f32x4){0.f, 0.f, 0.f, 0.f};
    u32x4* padp = (u32x4*)((bf16_t*)(ws + WS_WIN) + (size_t)NZC * DM);
    for (int i = gt; i < (NZP - NZC) * DM / 8; i += NGT) padp[i] = (u32x4){0u, 0u, 0u, 0u};
}

__device__ __forceinline__ void deferred_weights(const Params& p, LAS unsigned char* lds, int widx, int nw) {
    const int tid = ltid(), lane = tid & 63, wave = tid >> 6;
    LAS float* scr = (LAS float*)(lds + wave * 8704);
    unsigned char* ws = p.ws;
    constexpr int I_GU = (DM / 64) * (DFF / 32), I_D = (DFF / 64) * (DM / 32), I_IN = (DM / 64) * (NZC / 32), I_OUT = (DM / 64) * (DM / 32);
    constexpr int NITEMS = 2 * I_GU + I_D + I_IN + I_OUT;
    for (int it = widx; it < NITEMS; it += nw) {
        int r = it;
        if (r < I_IN) { transpose_item(p.in[7], DM, NZC, (bf16_t*)(ws + WS_WIN), 3, p.in[6], scr, r, lane); continue; } r -= I_IN;
        if (r < I_OUT) { transpose_item(p.in[13], DM, DM, (bf16_t*)(ws + WS_WOUT), 0, nullptr, scr, r, lane); continue; } r -= I_OUT;
        if (r < I_GU) { transpose_item(p.in[15], DM, DFF, (bf16_t*)(ws + WS_W2GU), 1, p.in[14], scr, r, lane); continue; } r -= I_GU;
        if (r < I_GU) { transpose_item(p.in[16], DM, DFF, (bf16_t*)(ws + WS_W2GU), 2, p.in[14], scr, r, lane); continue; } r -= I_GU;
        transpose_item(p.in[17], DFF, DM, (bf16_t*)(ws + WS_W2D), 0, nullptr, scr, r, lane);
    }
}

__device__ __forceinline__ void lr_gemm_item(const bf16_t* A, const bf16_t* Wt  , const float* ssq, bf16_t* Z, LAS unsigned char* lds, int item) {
    const int tid = ltid(), lane = tid & 63, wave = tid >> 6, fr = lane & 15, quad = lane >> 4; const int row0 = item * 64, k0 = wave * 128 + quad * 8;
    bf16x8 a[4][4], bw[2][4];
#pragma unroll
    for (int rt = 0; rt < 4; ++rt)
#pragma unroll
        for (int ks = 0; ks < 4; ++ks) a[rt][ks] = *(const bf16x8*)(A + (size_t)(row0 + rt * 16 + fr) * DM + k0 + ks * 32);
#pragma unroll
    for (int ct = 0; ct < 2; ++ct)
#pragma unroll
        for (int ks = 0; ks < 4; ++ks) bw[ct][ks] = *(const bf16x8*)(Wt + (size_t)(ct * 16 + fr) * DM + k0 + ks * 32);
    LAS float* part = (LAS float*)lds;
#pragma unroll
    for (int rt = 0; rt < 4; ++rt)
#pragma unroll
        for (int ct = 0; ct < 2; ++ct) { f32x4 acc = {0.f, 0.f, 0.f, 0.f};
#pragma unroll
            for (int ks = 0; ks < 4; ++ks) acc = __builtin_amdgcn_mfma_f32_16x16x32_bf16(a[rt][ks], bw[ct][ks], acc, 0, 0, 0);
#pragma unroll
            for (int j = 0; j < 4; ++j) part[(wave * 64 + rt * 16 + quad * 4 + j) * 32 + ct * 16 + fr] = acc[j]; }
    __syncthreads();
    { const int r = tid >> 3, c4 = (tid & 7) * 4; f32x4 s = {0.f, 0.f, 0.f, 0.f};
#pragma unroll
      for (int w = 0; w < 8; ++w) s += *(const LAS f32x4*)(part + (w * 64 + r) * 32 + c4);
      const float rs = rsqrtf(ssq[row0 + r] * (1.0f / DM) + EPS);
      u32x2 o; o.x = cvt_pk_bf16(s[0] * rs, s[1] * rs); o.y = cvt_pk_bf16(s[2] * rs, s[3] * rs);
      *(u32x2*)(Z + (size_t)(row0 + r) * NZ + ZLF + c4) = o; }
    __syncthreads();
}

struct EpiSwiglu {
    static constexpr bool PERM = true, AFTER_DRAIN = false;
    bf16_t* H; const float* ssq;
    __device__ __forceinline__ void operator()(const f32x4 (&acc)[2][2][4][2], const Unit& u, int wr, int wc, int fr, int fq) const {
        const int row0 = u.pm * 256 + wr * 64 + fr, hc0 = u.pn * 128 + wc * 16 + 4 * fq;
        const int hcs = (fq & 1) ? hc0 + 60 : hc0;
#pragma unroll
        for (int ai = 0; ai < 2; ++ai)
#pragma unroll
            for (int m = 0; m < 4; ++m) {
                const int row = row0 + ai * 128 + m * 16; const float rs = rsqrtf(ssq[row] * (1.0f / DM) + EPS), nrl = -LOG2E * rs, rs2 = rs * rs;
                u32x2 o[2];
#pragma unroll
                for (int bj = 0; bj < 2; ++bj) {
                    const f32x4 ga = acc[ai][bj][m][0], ua = acc[ai][bj][m][1]; float hv[4];
#pragma unroll
                    for (int j = 0; j < 4; ++j) hv[j] = (ga[j] * ua[j]) * (rs2 * __builtin_amdgcn_rcpf(1.0f + __builtin_amdgcn_exp2f(nrl * ga[j])));
                    o[bj].x = cvt_pk_bf16(hv[0], hv[1]); o[bj].y = cvt_pk_bf16(hv[2], hv[3]);
                }
                const auto rx = __builtin_amdgcn_permlane16_swap(o[0].x, o[1].x, false, false), ry = __builtin_amdgcn_permlane16_swap(o[0].y, o[1].y, false, false);
                u32x4 w; w.x = rx[0]; w.y = ry[0]; w.z = rx[1]; w.w = ry[1];
                *(u32x4*)(H + (size_t)row * DFF + hcs) = w;
            }
    }
};
template <bool BASE_BF16> struct EpiResid {
    static constexpr bool PERM = true, AFTER_DRAIN = false;
    const float* base0; const float* base1; int split; const bf16_t* baseb; bf16_t* ob; float* ssq; float alpha;
    __device__ __forceinline__ void operator()(const f32x4 (&acc)[2][2][4][2], const Unit& u, int wr, int wc, int fr, int fq) const {
        const int row0 = u.pm * 256 + wr * 64 + fr, c00 = u.pn * 256 + wc * 32 + 8 * fq;
        float ssum[2][4];
#pragma unroll
        for (int ai = 0; ai < 2; ++ai)
#pragma unroll
            for (int m = 0; m < 4; ++m) {
                const int row = row0 + ai * 128 + m * 16;
                float s = 0.f;
#pragma unroll
                for (int bj = 0; bj < 2; ++bj) {
                    const int c0 = c00 + bj * 128; f32x4 b0, b1;
                    if constexpr (BASE_BF16) { const u32x4 r = *(const u32x4*)(baseb + (size_t)row * DM + c0);
                        b0 = (f32x4){__uint_as_float(r.x << 16), __uint_as_float(r.x & 0xffff0000u), __uint_as_float(r.y << 16), __uint_as_float(r.y & 0xffff0000u)};
                        b1 = (f32x4){__uint_as_float(r.z << 16), __uint_as_float(r.z & 0xffff0000u), __uint_as_float(r.w << 16), __uint_as_float(r.w & 0xffff0000u)};
                    } else { const float* b = row < split ? base0 + (size_t)row * DM : base1 + (size_t)(row - split) * DM; b0 = *(const f32x4*)(b + c0); b1 = *(const f32x4*)(b + c0 + 4); }
                    const f32x4 v0 = b0 + acc[ai][bj][m][0] * alpha, v1 = b1 + acc[ai][bj][m][1] * alpha;
                    u32x4 w; w.x = cvt_pk_bf16(v0[0], v0[1]); w.y = cvt_pk_bf16(v0[2], v0[3]); w.z = cvt_pk_bf16(v1[0], v1[1]); w.w = cvt_pk_bf16(v1[2], v1[3]); *(u32x4*)(ob + (size_t)row * DM + c0) = w;
                    s += (v0[0] * v0[0] + v0[1] * v0[1]) + (v0[2] * v0[2] + v0[3] * v0[3]) + (v1[0] * v1[0] + v1[1] * v1[1]) + (v1[2] * v1[2] + v1[3] * v1[3]);
                }
                ssum[ai][m] = quad_sum(s);
            }
#pragma unroll
        for (int ai = 0; ai < 2; ++ai) { const float v = fq == 0 ? ssum[ai][0] : fq == 1 ? ssum[ai][1] : fq == 2 ? ssum[ai][2] : ssum[ai][3];
            atomicAdd(ssq + row0 + ai * 128 + fq * 16, v); }
    }
};
struct EpiZ {
    static constexpr bool PERM = true, AFTER_DRAIN = false;
    bf16_t* Z; const float* ssq;
    __device__ __forceinline__ void operator()(const f32x4 (&acc)[2][2][4][2], const Unit& u, int wr, int wc, int fr, int fq) const {
        const int row0 = u.pm * 256 + wr * 64 + fr, c00 = u.pn * 256 + wc * 32 + 8 * fq;
#pragma unroll
        for (int ai = 0; ai < 2; ++ai)
#pragma unroll
            for (int m = 0; m < 4; ++m) {
                const int row = row0 + ai * 128 + m * 16; const float rs = rsqrtf(ssq[row] * (1.0f / DM) + EPS);
#pragma unroll
                for (int bj = 0; bj < 2; ++bj) {
                    const int c0 = c00 + bj * 128;
                    if (c0 < NZC) { const f32x4 v0 = acc[ai][bj][m][0] * rs, v1 = acc[ai][bj][m][1] * rs;
                        u32x4 w; w.x = cvt_pk_bf16(v0[0], v0[1]); w.y = cvt_pk_bf16(v0[2], v0[3]); w.z = cvt_pk_bf16(v1[0], v1[1]); w.w = cvt_pk_bf16(v1[2], v1[3]);
                        *(u32x4*)(Z + (size_t)row * NZ + c0) = w; }
                }
            }
    }
};
#define XB_TMO      128
#define XB_XCNT(j)  (256  + 64 * (j))
#define XB_XSUB(j)  (1280 + 64 * (j))
#define XB_XGEN(j)  (2304 + 64 * (j))
#define XB_TOP      3328
#define XB_TOPGEN   3392
#define XCD_BAR_WORDS 3456
#define XB_SPIN_CAP (1u << 18)

__device__ __forceinline__ unsigned xb_ld(unsigned* p)              { return __hip_atomic_load(p, __ATOMIC_RELAXED, __HIP_MEMORY_SCOPE_AGENT); }
__device__ __forceinline__ unsigned xb_add(unsigned* p, unsigned v) { return __hip_atomic_fetch_add(p, v, __ATOMIC_RELAXED, __HIP_MEMORY_SCOPE_AGENT); }
__device__ __forceinline__ unsigned xb_xcc_id() { return (unsigned)__builtin_amdgcn_s_getreg((3 << 11) | 20) & 0xFu; }
#define XB_SPIN(cond, bar) do { unsigned _sp = 0; while (cond) { __builtin_amdgcn_s_sleep(1); \
    if ((++_sp & 255u) == 0u) { if (xb_ld(&(bar)[XB_TMO])) break; if (_sp > XB_SPIN_CAP) { atomicAdd(&(bar)[XB_TMO], 1u); break; } } } } while (0)

struct XcdBarrier {
    unsigned* bar; unsigned x;
    volatile LAS unsigned* st;
};

__device__ __forceinline__ XcdBarrier xcd_barrier_post(unsigned* bar, volatile LAS unsigned* st) {
    XcdBarrier b; b.bar = bar; b.x = xb_xcc_id(); b.st = st;
    if (threadIdx.x == 0) (void)xb_add(&bar[XB_XCNT(b.x)], 1u);
    return b;
}
__device__ __forceinline__ void xcd_barrier_complete(unsigned* bar, unsigned x, unsigned& nloc, unsigned& nx) {
    const unsigned G = gridDim.x * gridDim.y * gridDim.z;
    unsigned sum, cnt, mine, sp = 0u;
    for (;;) {
        sum = 0u; cnt = 0u; mine = 0u;
#pragma unroll
        for (unsigned j = 0; j < 16; ++j) { const unsigned c = xb_ld(&bar[XB_XCNT(j)]); sum += c; cnt += (c > 0u) ? 1u : 0u; mine = (j == x) ? c : mine; }
        if (sum == G) break;
        __builtin_amdgcn_s_sleep(1);
        if ((++sp & 255u) == 0u) { if (xb_ld(&bar[XB_TMO])) break; if (sp > XB_SPIN_CAP) { atomicAdd(&bar[XB_TMO], 1u); break; } }
    }
    nloc = mine > 0u ? mine : 1u; nx = cnt > 0u ? cnt : 1u;
}

__device__ __forceinline__ void xcd_barrier(const XcdBarrier& b) {
    asm volatile("s_waitcnt vmcnt(0)" ::: "memory");
    __syncthreads();
    if (threadIdx.x == 0) {
        unsigned* bar = b.bar;
        __builtin_amdgcn_s_waitcnt(0);
        unsigned nloc = b.st[0], nx = b.st[1];
        if (nloc == 0u) { xcd_barrier_complete(bar, b.x, nloc, nx); b.st[0] = nloc; b.st[1] = nx; }
        const unsigned old = xb_add(&bar[XB_XSUB(b.x)], 1u);
        const unsigned gen = old / nloc;
        if (old + 1u == (gen + 1u) * nloc) {
            __builtin_amdgcn_fence(__ATOMIC_RELEASE, "agent");
            asm volatile("s_waitcnt vmcnt(0)" ::: "memory");
            const unsigned og = xb_add(&bar[XB_TOP], 1u);
            const unsigned tg = og / nx;
            if (og + 1u == (tg + 1u) * nx) xb_add(&bar[XB_TOPGEN], 1u);
            else XB_SPIN(xb_ld(&bar[XB_TOPGEN]) == tg, bar);
            __builtin_amdgcn_fence(__ATOMIC_ACQUIRE, "agent");
            xb_add(&bar[XB_XGEN(b.x)], 1u);
            asm volatile("s_waitcnt vmcnt(0)" ::: "memory");
        } else {
            XB_SPIN(xb_ld(&bar[XB_XGEN(b.x)]) == gen, bar);
            __builtin_amdgcn_fence(__ATOMIC_ACQUIRE, "agent");
            asm volatile("s_waitcnt vmcnt(0)" ::: "memory");
        }
    }
    __syncthreads();
}

#define MFMA16(a, b, c) __builtin_amdgcn_mfma_f32_16x16x32_bf16((a), (b), (c), 0, 0, 0)
typedef __bf16 bf2_t __attribute__((ext_vector_type(2)));
__device__ __forceinline__ float dot2bf(unsigned a, unsigned b, float c) { return __builtin_amdgcn_fdot2_f32_bf16(__builtin_bit_cast(bf2_t, a), __builtin_bit_cast(bf2_t, b), c, false); }
__device__ __forceinline__ bf16_t f2bf1(float x) { return (bf16_t)cvt_pk_bf16(x, 0.f); }
constexpr int GL_LR = 0  , GL_WA = 8192, GL_BA = 16384, GL_TOT = 16896, GL_VT = 18944  , GL_A = 37376  , GL_P = 74240  , GL_SS = 83456  , GL_KR = 85504  , GL_QR = 94720  ;

__device__ __forceinline__ void gla_load(const Params& p, const bf16_t* Z, LAS unsigned char* lds, int gc, int h, bool withq) {
    const int tid = ltid(); const size_t tok0 = (size_t)gc * 64;
    LAS unsigned* lr = (LAS unsigned*)(lds + GL_LR); LAS float* wa = (LAS float*)(lds + GL_WA); LAS float* ba = (LAS float*)(lds + GL_BA); LAS bf16_t* vT = (LAS bf16_t*)(lds + GL_VT);
    { const int t = tid >> 3, r4 = (tid & 7) * 4; const u32x2 raw = *(const u32x2*)(Z + (tok0 + t) * NZ + ZLF + r4);
      *(LAS u32x2*)(lr + ((r4 >> 4) * 64 + t) * 8 + ((r4 & 15) >> 1)) = raw; }
    { const int dir = tid >> 8, r = (tid >> 4) & 15, kk4 = (tid & 15) * 4; const float* src = (dir ? p.in[10] : p.in[8]) + r * 256 + h * 64 + kk4;
      *(LAS f32x4*)(wa + (dir * 16 + r) * 64 + kk4) = *(const f32x4*)src; }
    { const int t = tid >> 3, k8 = (tid & 7) * 8;
      *(LAS u32x4*)(lds + GL_KR + (t * 72 + k8) * 2) = *(const u32x4*)(Z + (tok0 + t) * NZ + ZK + h * 64 + k8);
      if (withq) *(LAS u32x4*)(lds + GL_QR + (t * 72 + k8) * 2) = *(const u32x4*)(Z + (tok0 + t) * NZ + ZQ + h * 64 + k8); }
    if (tid < 128) { const int dir = tid >> 6, kk = tid & 63; ba[dir * 64 + kk] = (dir ? p.in[11] : p.in[9])[h * 64 + kk]; }
    { const int t = tid >> 3, dv0 = (tid & 7) * 16; const u32x4* src = (const u32x4*)(Z + (tok0 + t) * NZ + ZV + h * 128 + dv0); const u32x4 a = src[0], b = src[1];
      const unsigned wv[8] = {a.x, a.y, a.z, a.w, b.x, b.y, b.z, b.w};
#pragma unroll
      for (int e = 0; e < 8; ++e) { vT[(dv0 + 2 * e) * 72 + t] = (bf16_t)(wv[e] & 0xffffu); vT[(dv0 + 2 * e + 1) * 72 + t] = (bf16_t)(wv[e] >> 16); } }
    __syncthreads();
}
__device__ __forceinline__ void gla_gates(LAS unsigned char* lds, float (&c)[16], float (&la)[16], float& off, float& all) {
    const int tid = ltid(), dir = tid >> 8, qtr = (tid >> 6) & 3, kk = tid & 63;
    LAS unsigned* lr = (LAS unsigned*)(lds + GL_LR); LAS float* wa = (LAS float*)(lds + GL_WA); LAS float* ba = (LAS float*)(lds + GL_BA); LAS float* tot = (LAS float*)(lds + GL_TOT);
    unsigned w2[8];
#pragma unroll
    for (int r = 0; r < 8; ++r) w2[r] = cvt_pk_bf16(wa[(dir * 16 + 2 * r) * 64 + kk], wa[(dir * 16 + 2 * r + 1) * 64 + kk]);
    const float bias = ba[dir * 64 + kk]; float run = 0.f;
#pragma unroll
    for (int gb = 0; gb < 2; ++gb) {
        u32x4 L[8][2];
#pragma unroll
        for (int i = 0; i < 8; ++i) { const LAS u32x4* l4 = (const LAS u32x4*)(lr + (dir * 64 + qtr * 16 + gb * 8 + i) * 8); L[i][0] = l4[0]; L[i][1] = l4[1]; }
        asm volatile("s_waitcnt lgkmcnt(0)" ::: "memory");
#pragma unroll
        for (int i = 0; i < 8; ++i) { const u32x4 v0 = L[i][0], v1 = L[i][1];
            float x = bias, y = 0.f;
            x = dot2bf(v0.x, w2[0], x); y = dot2bf(v0.y, w2[1], y); x = dot2bf(v0.z, w2[2], x); y = dot2bf(v0.w, w2[3], y);
            x = dot2bf(v1.x, w2[4], x); y = dot2bf(v1.y, w2[5], y); x = dot2bf(v1.z, w2[6], x); y = dot2bf(v1.w, w2[7], y);
            x += y;
            const float li = -(fmaxf(-x, 0.f) + 0.6931471805599453f * __builtin_amdgcn_logf(1.0f + __builtin_amdgcn_exp2f(-LOG2E * fabsf(x)))) * (1.0f / 16.0f);
            run += li; c[gb * 8 + i] = run; la[gb * 8 + i] = li; }
    }
    tot[(dir * 4 + qtr) * 64 + kk] = run;
    lds_barrier();
    off = 0.f; all = 0.f;
#pragma unroll
    for (int q = 0; q < 4; ++q) { const float v = tot[(dir * 4 + q) * 64 + kk]; all += v; if (q < qtr) off += v; }
}

__device__ __forceinline__ unsigned gla_touch(const Params& p, int un, bool states) {
    const bf16_t* Z = (const bf16_t*)(p.ws + WS_BIG); const int tid = ltid(); unsigned r = 0u;
    if (GLA_TOUCH && un < NCHUNK * 4) { const int gc = un >> 2, h = un & 3;
        if (tid < 448) { const int t = tid & 63, w = tid >> 6; const int col = w == 0 ? ZQ + h * 64 : w == 1 ? ZK + h * 64 : w == 2 ? ZV + h * 128 : w == 3 ? ZV + h * 128 + 64 : w == 4 ? ZR + h * 128 : w == 5 ? ZR + h * 128 + 64 : ZLF;
            r = *(const unsigned*)(Z + ((size_t)gc * 64 + t) * NZ + col); }
        if (states && tid < 256) r ^= *(const unsigned*)((const bf16_t*)(p.ws + WS_ST) + (size_t)(gc * 4 + h) * 2 * 8192 + tid * 64); }
    return r;
}
__device__ __forceinline__ void gla_g1_unit(const Params& p, LAS unsigned char* lds, int gc, int h, int un) {
    const bf16_t* Z = (const bf16_t*)(p.ws + WS_BIG); bf16_t* ST = (bf16_t*)(p.ws + WS_ST); float* DEC = (float*)(p.ws + WS_DEC);
    const int tid = ltid(), lane = tid & 63, wave = tid >> 6, dir = tid >> 8, qtr = (tid >> 6) & 3, kk = tid & 63; const size_t tok0 = (size_t)gc * 64;
    gla_load(p, Z, lds, gc, h, false);
    const LAS bf16_t* kraw = (const LAS bf16_t*)(lds + GL_KR) + (qtr * 16) * 72 + kk;
    float c[16], la[16], off, all; gla_gates(lds, c, la, off, all);
    LAS bf16_t* KeT = (LAS bf16_t*)(lds + GL_A);
#pragma unroll
    for (int i = 0; i < 16; ++i) { const int t = qtr * 16 + i; const float e = __builtin_amdgcn_exp2f(LOG2E * (dir == 0 ? all - (off + c[i]) : off + c[i] - la[i]));
        KeT[(dir * 64 + kk) * 72 + t] = f2bf1(bf2f(kraw[i * 72]) * e); }
    if (qtr == 0) DEC[((size_t)(gc * 4 + h) * 2 + dir) * 64 + kk] = __builtin_amdgcn_exp2f(LOG2E * all);
    lds_barrier();
    { const LAS bf16_t* vT = (const LAS bf16_t*)(lds + GL_VT); const int wd = wave >> 2, wq = wave & 3, fr = lane & 15, quad = lane >> 4;
      bf16_t* dst = ST + ((size_t)(gc * 4 + h) * 2 + wd) * 8192;
#pragma unroll
      for (int dd = 0; dd < 2; ++dd) { const int dvt = 2 * wq + dd; bf16x8 b[2];
#pragma unroll
        for (int ks = 0; ks < 2; ++ks) b[ks] = *(const LAS bf16x8*)(vT + (dvt * 16 + fr) * 72 + ks * 32 + quad * 8);
#pragma unroll
        for (int kp = 0; kp < 2; ++kp) { u32x2 o[2];
#pragma unroll
          for (int kq = 0; kq < 2; ++kq) { const int kt = 2 * kp + kq; f32x4 acc = {0.f, 0.f, 0.f, 0.f};
#pragma unroll
            for (int ks = 0; ks < 2; ++ks) { const bf16x8 a = *(const LAS bf16x8*)(KeT + (wd * 64 + kt * 16 + fr) * 72 + ks * 32 + quad * 8); acc = MFMA16(a, b[ks], acc); }
            o[kq].x = cvt_pk_bf16(acc[0], acc[1]); o[kq].y = cvt_pk_bf16(acc[2], acc[3]); }
          const auto rx = __builtin_amdgcn_permlane16_swap(o[0].x, o[1].x, false, false), ry = __builtin_amdgcn_permlane16_swap(o[0].y, o[1].y, false, false);
          u32x4 w; w.x = rx[0]; w.y = ry[0]; w.z = rx[1]; w.w = ry[1];
          const int ko = (quad & 1) ? (2 * kp + 1) * 16 + (quad - 1) * 4 : (2 * kp) * 16 + quad * 4;
          *(u32x4*)(dst + (dvt * 16 + fr) * 64 + ko) = w; } } }
    lds_barrier();
}

template <int EL, int NB> __device__ __forceinline__ void g2_scan(bf16_t* ST, const float* DEC, int c0, int n, int h, int dir, int eo) {
    const int k0 = eo & 63;
    float S[EL];
#pragma unroll
    for (int e = 0; e < EL; ++e) S[e] = 0.f;
    for (int i0 = 0; i0 < n; i0 += NB) {
        unsigned kv[NB][EL / 2]; float d[NB][EL];
#pragma unroll
        for (int u = 0; u < NB; ++u) { const int i = i0 + u, c = dir == 0 ? c0 + i : c0 + n - 1 - i; const size_t slot = (size_t)(c * 4 + h) * 2 + dir;
            if constexpr (EL == 8) { const u32x4 t = *(const u32x4*)(ST + slot * 8192 + eo); kv[u][0] = t.x; kv[u][1] = t.y; kv[u][2] = t.z; kv[u][3] = t.w; }
            else { const u32x2 t = *(const u32x2*)(ST + slot * 8192 + eo); kv[u][0] = t.x; kv[u][1] = t.y; }
#pragma unroll
            for (int q = 0; q < EL / 4; ++q) { const f32x4 t = *(const f32x4*)(DEC + slot * 64 + k0 + 4 * q); d[u][4 * q] = t[0]; d[u][4 * q + 1] = t[1]; d[u][4 * q + 2] = t[2]; d[u][4 * q + 3] = t[3]; } }
#pragma unroll
        for (int u = 0; u < NB; ++u) {
            const int i = i0 + u, c = dir == 0 ? c0 + i : c0 + n - 1 - i; const size_t slot = (size_t)(c * 4 + h) * 2 + dir;
            if constexpr (EL == 8) { u32x4 o; o.x = cvt_pk_bf16(S[0], S[1]); o.y = cvt_pk_bf16(S[2], S[3]); o.z = cvt_pk_bf16(S[4], S[5]); o.w = cvt_pk_bf16(S[6], S[7]); *(u32x4*)(ST + slot * 8192 + eo) = o; }
            else { u32x2 o; o.x = cvt_pk_bf16(S[0], S[1]); o.y = cvt_pk_bf16(S[2], S[3]); *(u32x2*)(ST + slot * 8192 + eo) = o; }
#pragma unroll
            for (int e = 0; e < EL / 2; ++e) { S[2 * e] = d[u][2 * e] * S[2 * e] + __uint_as_float(kv[u][e] << 16); S[2 * e + 1] = d[u][2 * e + 1] * S[2 * e + 1] + __uint_as_float(kv[u][e] & 0xffff0000u); }
        }
    }
}
__device__ __forceinline__ void gla_g2(const Params& p) {
    bf16_t* ST = (bf16_t*)(p.ws + WS_ST); const float* DEC = (const float*)(p.ws + WS_DEC);
    const int tid = ltid(), lane = tid & 63, wave = tid >> 6; const int gw = blockIdx.x * 8 + wave, NGW = gridDim.x * 8;
    if (gw < 256) { const int r = gw, h = r >> 6, dir = (r >> 5) & 1, part = r & 31; g2_scan<4, 16>(ST, DEC, 1024, 256, h, dir, part * 256 + lane * 4); }
    else if (NGW > 256) for (int it = gw - 256; it < 4096; it += NGW - 256) { const int c0 = (it >> 7) * 32, r = it & 127, h = r >> 5, dir = (r >> 4) & 1, part = r & 15; g2_scan<8, 8>(ST, DEC, c0, 32, h, dir, part * 512 + lane * 8); }
}

__device__ __forceinline__ void gla_g3_unit(const Params& p, LAS unsigned char* lds, int gc, int h, int un) {
    const bf16_t* Z = (const bf16_t*)(p.ws + WS_BIG); const bf16_t* ST = (const bf16_t*)(p.ws + WS_ST); bf16_t* OC = (bf16_t*)(p.ws + WS_ACTA);
    const int tid = ltid(), lane = tid & 63, wave = tid >> 6, dir = tid >> 8, qtr = (tid >> 6) & 3, kk = tid & 63, fr = lane & 15, quad = lane >> 4; const size_t tok0 = (size_t)gc * 64;
    u32x2 rr[4]; bf16x8 bf_[2], bb[2];
#pragma unroll
    for (int ti = 0; ti < 4; ++ti) rr[ti] = *(const u32x2*)(Z + (tok0 + ti * 16 + fr) * NZ + ZR + h * 128 + wave * 16 + quad * 4);
    { const bf16_t* Sf = ST + ((size_t)(gc * 4 + h) * 2 + 0) * 8192; const bf16_t* Sb = Sf + 8192;
#pragma unroll
      for (int ks = 0; ks < 2; ++ks) { const int o = ks * 32 + quad * 8; bf_[ks] = *(const bf16x8*)(Sf + (wave * 16 + fr) * 64 + o); bb[ks] = *(const bf16x8*)(Sb + (wave * 16 + fr) * 64 + o); } }
    gla_load(p, Z, lds, gc, h, true);
    const LAS bf16_t* kraw = (const LAS bf16_t*)(lds + GL_KR) + (qtr * 16) * 72 + kk; const LAS bf16_t* qraw = (const LAS bf16_t*)(lds + GL_QR) + (qtr * 16) * 72 + kk;
    float c[16], la[16], off, all; gla_gates(lds, c, la, off, all);
    LAS bf16_t* QK = (LAS bf16_t*)(lds + GL_A);
    { LAS bf16_t* Qd = QK + (dir * 2) * 64 * 72; LAS bf16_t* Kd = Qd + 64 * 72;
#pragma unroll
      for (int i = 0; i < 16; ++i) { const int t = qtr * 16 + i; const float b = dir == 0 ? off + c[i] : all - (off + c[i]) + la[i];
        const float b2 = LOG2E * b; Qd[t * 72 + kk] = f2bf1(bf2f(qraw[i * 72]) * __builtin_amdgcn_exp2f(b2)); Kd[t * 72 + kk] = f2bf1(bf2f(kraw[i * 72]) * __builtin_amdgcn_exp2f(-b2)); } }
    lds_barrier();
    const LAS bf16_t* Qf = QK; const LAS bf16_t* Kf = QK + 64 * 72; const LAS bf16_t* Qb = QK + 2 * 64 * 72; const LAS bf16_t* Kb = QK + 3 * 64 * 72;
    LAS bf16_t* P = (LAS bf16_t*)(lds + GL_P); const LAS bf16_t* vT = (const LAS bf16_t*)(lds + GL_VT);
#pragma unroll
    for (int pp = 0; pp < 2; ++pp) { const int pt = 2 * wave + pp, ti = pt >> 2, tj = pt & 3; f32x4 af = {0.f, 0.f, 0.f, 0.f}, ab = {0.f, 0.f, 0.f, 0.f};
#pragma unroll
        for (int ks = 0; ks < 2; ++ks) { const int o = ks * 32 + quad * 8;
            af = MFMA16(*(const LAS bf16x8*)(Kf + (tj * 16 + fr) * 72 + o), *(const LAS bf16x8*)(Qf + (ti * 16 + fr) * 72 + o), af);
            ab = MFMA16(*(const LAS bf16x8*)(Kb + (tj * 16 + fr) * 72 + o), *(const LAS bf16x8*)(Qb + (ti * 16 + fr) * 72 + o), ab); }
        float pv[4];
#pragma unroll
        for (int j = 0; j < 4; ++j) { const int s = tj * 16 + quad * 4 + j, t = ti * 16 + fr; pv[j] = (s <= t ? af[j] : 0.f) + (s >= t ? ab[j] : 0.f); }
        u32x2 o; o.x = cvt_pk_bf16(pv[0], pv[1]); o.y = cvt_pk_bf16(pv[2], pv[3]);
        *(LAS u32x2*)(P + (ti * 16 + fr) * 72 + tj * 16 + quad * 4) = o; }
    lds_barrier();
    f32x4 acc[4];
    { bf16x8 av[2];
#pragma unroll
      for (int ks = 0; ks < 2; ++ks) av[ks] = *(const LAS bf16x8*)(vT + (wave * 16 + fr) * 72 + ks * 32 + quad * 8);
#pragma unroll
      for (int ti = 0; ti < 4; ++ti) { f32x4 a = {0.f, 0.f, 0.f, 0.f};
#pragma unroll
          for (int ks = 0; ks < 2; ++ks) { const int o = ks * 32 + quad * 8;
              a = MFMA16(av[ks], *(const LAS bf16x8*)(P + (ti * 16 + fr) * 72 + o), a);
              a = MFMA16(bf_[ks], *(const LAS bf16x8*)(Qf + (ti * 16 + fr) * 72 + o), a);
              a = MFMA16(bb[ks], *(const LAS bf16x8*)(Qb + (ti * 16 + fr) * 72 + o), a); }
          acc[ti] = a; } }
    LAS float* ssw = (LAS float*)(lds + GL_SS);
#pragma unroll
    for (int ti = 0; ti < 4; ++ti) { float s = (acc[ti][0] * acc[ti][0] + acc[ti][1] * acc[ti][1]) + (acc[ti][2] * acc[ti][2] + acc[ti][3] * acc[ti][3]);
        s = quad_sum(s); if (quad == 0) ssw[wave * 64 + ti * 16 + fr] = s; }
    lds_barrier();
    { const int dv0 = h * 128 + wave * 16 + quad * 4; const f32x4 g = *(const f32x4*)(p.in[12] + dv0);
      u32x2 oo[4];
#pragma unroll
      for (int ti = 0; ti < 4; ++ti) { const int t = ti * 16 + fr; float tot = 0.f;
#pragma unroll
          for (int w8 = 0; w8 < 8; ++w8) tot += ssw[w8 * 64 + t];
          const float rinv = rsqrtf(tot * (1.0f / 128.0f) + EPS);
          const float r0 = __uint_as_float(rr[ti].x << 16), r1 = __uint_as_float(rr[ti].x & 0xffff0000u), r2 = __uint_as_float(rr[ti].y << 16), r3 = __uint_as_float(rr[ti].y & 0xffff0000u);
#define SILU_(r_) ((r_) * __builtin_amdgcn_rcpf(1.0f + __builtin_amdgcn_exp2f(-LOG2E * (r_))))
          oo[ti].x = cvt_pk_bf16(acc[ti][0] * rinv * g[0] * SILU_(r0), acc[ti][1] * rinv * g[1] * SILU_(r1));
          oo[ti].y = cvt_pk_bf16(acc[ti][2] * rinv * g[2] * SILU_(r2), acc[ti][3] * rinv * g[3] * SILU_(r3));
#undef SILU_
      }
#pragma unroll
      for (int tp = 0; tp < 2; ++tp) {
          const auto rx = __builtin_amdgcn_permlane16_swap(oo[2 * tp].x, oo[2 * tp + 1].x, false, false), ry = __builtin_amdgcn_permlane16_swap(oo[2 * tp].y, oo[2 * tp + 1].y, false, false);
          u32x4 w; w.x = rx[0]; w.y = ry[0]; w.z = rx[1]; w.w = ry[1];
          const int t = ((quad & 1) ? 2 * tp + 1 : 2 * tp) * 16 + fr, dvs = (quad & 1) ? dv0 - 4 : dv0;
          *(u32x4*)(OC + (tok0 + t) * DM + dvs) = w; } }
    lds_barrier();
}
constexpr int AT_TILE = 512, AT_O = 0  , AT_M = AT_TILE * 68 * 4, AT_L = AT_M + AT_TILE * 4;
__device__ __forceinline__ void attn_group(int br, int g, int p0, int& cls, int& qi) {
    if (br == 0) { cls = 0; qi = p0 + 32 * g; } else if (br == 1) { cls = g >> 2; qi = (p0 >> 2) + 32 * (g & 3); } else { cls = g; qi = p0 >> 4; }
}
__device__ __forceinline__ void attn_load(const bf16_t* Zh, int s0, int sh, int n, int cls, int kb, int lane, bf16x8 (&k)[4], bf16x8 (&v)[4]) {
    const int fr = lane & 15, quad = lane >> 4;
    if (kb >= 0 && kb + 32 <= n) {
        const unsigned o0 = (unsigned)(s0 + ((kb + fr) << sh) + cls) * (unsigned)NZ + quad * 8, o1 = o0 + ((unsigned)(16 << sh)) * (unsigned)NZ;
        k[0] = *(const bf16x8*)(Zh + o0 + ZAK); k[1] = *(const bf16x8*)(Zh + o0 + ZAK + 32); v[0] = *(const bf16x8*)(Zh + o0 + ZAV); v[1] = *(const bf16x8*)(Zh + o0 + ZAV + 32);
        k[2] = *(const bf16x8*)(Zh + o1 + ZAK); k[3] = *(const bf16x8*)(Zh + o1 + ZAK + 32); v[2] = *(const bf16x8*)(Zh + o1 + ZAV); v[3] = *(const bf16x8*)(Zh + o1 + ZAV + 32);
    } else {
#pragma unroll
        for (int kt = 0; kt < 2; ++kt) { int ki = kb + kt * 16 + fr; ki = ki < 0 ? 0 : (ki >= n ? n - 1 : ki);
            const bf16_t* r = Zh + (unsigned)(s0 + (ki << sh) + cls) * (unsigned)NZ + quad * 8;
            k[kt * 2] = *(const bf16x8*)(r + ZAK); k[kt * 2 + 1] = *(const bf16x8*)(r + ZAK + 32); v[kt * 2] = *(const bf16x8*)(r + ZAV); v[kt * 2 + 1] = *(const bf16x8*)(r + ZAV + 32); }
    }
}
__device__ __forceinline__ void attn_unit(const Params& p, LAS unsigned char* lds, int tile, int h, int variant) {
    const bf16_t* Zh = (const bf16_t*)(p.ws + WS_BIG) + h * 64; bf16_t* OC = (bf16_t*)(p.ws + WS_ACTA);
    const int tid = ltid(), lane = tid & 63, wave = tid >> 6, fr = lane & 15, quad = lane >> 4;
    const int T0 = tile * AT_TILE, s0 = T0 < MPROMPT ? (T0 & ~2047) : MPROMPT, L = T0 < MPROMPT ? 2048 : 16384, p0 = T0 - s0;
    LAS float* Ol = (LAS float*)(lds + AT_O); LAS float* ml = (LAS float*)(lds + AT_M); LAS float* ll = (LAS float*)(lds + AT_L);
    const float slope2 = exp2f(-(float)(h + 1)) * LOG2E;
    bf16x8 isel[2];
#pragma unroll
    for (int hf = 0; hf < 2; ++hf)
#pragma unroll
        for (int jj = 0; jj < 8; ++jj) isel[hf][jj] = (quad * 8 + jj == hf * 16 + fr) ? (short)0x3F80 : (short)0;
#pragma unroll 1
    for (int br = 0; br < 3; ++br) {
        const int sh = 2 * br, n = L >> sh; const float nbc = -slope2 * (float)(1 << sh);
        bf16x8 kf[4], vf[4];
        { int cls, qi; attn_group(br, 2 * wave, p0, cls, qi); attn_load(Zh, s0, sh, n, cls, qi - 64, lane, kf, vf); }
        bf16x8 qf[2][2]; float m[2], l[2]; f32x4 O[2][4]; int tq[2], tl[2];
#pragma unroll
        for (int nt = 0; nt < 2; ++nt) { m[nt] = -1e30f; l[nt] = 0.f; tq[nt] = 0; tl[nt] = 0; qf[nt][0] = kf[0]; qf[nt][1] = kf[0];
#pragma unroll
            for (int dt = 0; dt < 4; ++dt) O[nt][dt] = (f32x4){0.f, 0.f, 0.f, 0.f}; }
#pragma unroll 1
        for (int it = 0; it < 10; ++it) {
            const int gg = it >= 5 ? 1 : 0, ch = it - 5 * gg;
            int cls, qi; attn_group(br, 2 * wave + gg, p0, cls, qi);
            if (ch == 0) {
#pragma unroll
                for (int nt = 0; nt < 2; ++nt) {
                    tq[nt] = s0 + ((qi + 16 * nt + fr) << sh) + cls; tl[nt] = tq[nt] - T0;
#pragma unroll
                    for (int ks = 0; ks < 2; ++ks) qf[nt][ks] = *(const bf16x8*)(Zh + (unsigned)tq[nt] * (unsigned)NZ + ZAQ + ks * 32 + quad * 8);
                    if (br == 0) { m[nt] = -1e30f; l[nt] = 0.f;
#pragma unroll
                        for (int dt = 0; dt < 4; ++dt) O[nt][dt] = (f32x4){0.f, 0.f, 0.f, 0.f};
                    } else { m[nt] = ml[tl[nt]]; l[nt] = quad == 0 ? ll[tl[nt]] : 0.f;
#pragma unroll
                        for (int dt = 0; dt < 4; ++dt) O[nt][dt] = *(const LAS f32x4*)(Ol + tl[nt] * 68 + dt * 16 + quad * 4); }
                }
            }
            const int kb = qi - 64 + 32 * ch;
            f32x4 S[2][2], vt[2][4];
#pragma unroll
            for (int nt = 0; nt < 2; ++nt)
#pragma unroll
                for (int kt = 0; kt < 2; ++kt) { f32x4 a = {0.f, 0.f, 0.f, 0.f}; a = MFMA16(kf[kt * 2], qf[nt][0], a); a = MFMA16(kf[kt * 2 + 1], qf[nt][1], a); S[nt][kt] = a; }
#pragma unroll
            for (int kt = 0; kt < 2; ++kt)
#pragma unroll
                for (int dt = 0; dt < 4; ++dt) vt[kt][dt] = MFMA16(vf[kt * 2 + (dt >> 1)], isel[dt & 1], ((f32x4){0.f, 0.f, 0.f, 0.f}));
            if (it < 9 && variant != 1) { const int g2 = it + 1 >= 5 ? 1 : 0, ch2 = it + 1 - 5 * g2; int cls2, qi2; attn_group(br, 2 * wave + g2, p0, cls2, qi2);
                attn_load(Zh, s0, sh, n, cls2, qi2 - 64 + 32 * ch2, lane, kf, vf); }
            bf16x8 vtp[4];
#pragma unroll
            for (int dt = 0; dt < 4; ++dt) { u32x4 vw; vw.x = cvt_pk_bf16(vt[0][dt][0], vt[0][dt][1]); vw.y = cvt_pk_bf16(vt[0][dt][2], vt[0][dt][3]); vw.z = cvt_pk_bf16(vt[1][dt][0], vt[1][dt][1]); vw.w = cvt_pk_bf16(vt[1][dt][2], vt[1][dt][3]);
                vtp[dt] = __builtin_bit_cast(bf16x8, vw); }
            const bool seqedge = (kb < 0 || kb + 32 > n);
#pragma unroll
            for (int nt = 0; nt < 2; ++nt) {
                float sv[8]; float mx = -1e30f;
                const int relb = -64 + 32 * ch + quad * 4 - fr - 16 * nt;
                if (seqedge) {
#pragma unroll
                    for (int kt = 0; kt < 2; ++kt)
#pragma unroll
                        for (int j = 0; j < 4; ++j) { const int rel = relb + kt * 16 + j, key = qi + 16 * nt + fr + rel, ar = rel < 0 ? -rel : rel;
                            const bool ok = (ar <= 64) && ((unsigned)key < (unsigned)n); const float s = ok ? fmaf(nbc, (float)ar, S[nt][kt][j]) : -3.0e38f; sv[kt * 4 + j] = s; mx = fmaxf(mx, s); }
                } else { const float frel = (float)relb; const int dl = fr + 16 * nt - quad * 4;
                    if (ch == 0) {
#pragma unroll
                        for (int kt = 0; kt < 2; ++kt)
#pragma unroll
                            for (int j = 0; j < 4; ++j) { float s = fmaf(nbc, fabsf(frel + (float)(kt * 16 + j)), S[nt][kt][j]); s = (kt * 16 + j >= dl) ? s : -3.0e38f; sv[kt * 4 + j] = s; mx = fmaxf(mx, s); }
                    } else if (ch == 4) {
#pragma unroll
                        for (int kt = 0; kt < 2; ++kt)
#pragma unroll
                            for (int j = 0; j < 4; ++j) { float s = fmaf(nbc, fabsf(frel + (float)(kt * 16 + j)), S[nt][kt][j]); s = (kt * 16 + j <= dl) ? s : -3.0e38f; sv[kt * 4 + j] = s; mx = fmaxf(mx, s); }
                    } else {
#pragma unroll
                        for (int kt = 0; kt < 2; ++kt)
#pragma unroll
                            for (int j = 0; j < 4; ++j) { const float s = fmaf(nbc, fabsf(frel + (float)(kt * 16 + j)), S[nt][kt][j]); sv[kt * 4 + j] = s; mx = fmaxf(mx, s); }
                    }
                }
                if (!__all(mx - m[nt] <= 8.0f)) {
                    mx = quad_max(mx);
                    const float mn = fmaxf(m[nt], mx), alpha = __builtin_amdgcn_exp2f(m[nt] - mn);
                    l[nt] *= alpha; m[nt] = mn;
#pragma unroll
                    for (int dt = 0; dt < 4; ++dt) O[nt][dt] = O[nt][dt] * alpha;
                }
                float ps = 0.f; float pv[8]; const float mcur = m[nt];
#pragma unroll
                for (int e = 0; e < 8; ++e) { pv[e] = __builtin_amdgcn_exp2f(sv[e] - mcur); ps += pv[e]; }
                l[nt] += ps;
                u32x4 pw; pw.x = cvt_pk_bf16(pv[0], pv[1]); pw.y = cvt_pk_bf16(pv[2], pv[3]); pw.z = cvt_pk_bf16(pv[4], pv[5]); pw.w = cvt_pk_bf16(pv[6], pv[7]);
                const bf16x8 pf = __builtin_bit_cast(bf16x8, pw);
#pragma unroll
                for (int dt = 0; dt < 4; ++dt) O[nt][dt] = MFMA16(vtp[dt], pf, O[nt][dt]);
            }
            if (ch == 4) {
#pragma unroll
                for (int nt = 0; nt < 2; ++nt) {
                    const float lt = quad_sum(l[nt]);
                    if (br < 2) { if (quad == 0) { ml[tl[nt]] = m[nt]; ll[tl[nt]] = lt; }
#pragma unroll
                        for (int dt = 0; dt < 4; ++dt) *(LAS f32x4*)(Ol + tl[nt] * 68 + dt * 16 + quad * 4) = O[nt][dt];
                    } else { const float inv = 1.0f / lt; u32x2 oo[4];
#pragma unroll
                        for (int dt = 0; dt < 4; ++dt) { oo[dt].x = cvt_pk_bf16(O[nt][dt][0] * inv, O[nt][dt][1] * inv); oo[dt].y = cvt_pk_bf16(O[nt][dt][2] * inv, O[nt][dt][3] * inv); }
#pragma unroll
                        for (int dp = 0; dp < 2; ++dp) {
                            const auto rx = __builtin_amdgcn_permlane16_swap(oo[2 * dp].x, oo[2 * dp + 1].x, false, false), ry = __builtin_amdgcn_permlane16_swap(oo[2 * dp].y, oo[2 * dp + 1].y, false, false);
                            u32x4 w; w.x = rx[0]; w.y = ry[0]; w.z = rx[1]; w.w = ry[1];
                            const int col = (quad & 1) ? (2 * dp + 1) * 16 + (quad - 1) * 4 : (2 * dp) * 16 + quad * 4;
                            *(u32x4*)(OC + (size_t)tq[nt] * DM + 512 + h * 64 + col) = w; } }
                }
            }
        }
        lds_barrier();
    }
}
__global__ void __launch_bounds__(NTHREADS, 2) hymba_fwd(Params p) {
    extern __shared__ __attribute__((aligned(16))) unsigned char smem[];
    LAS unsigned char* lds = (LAS unsigned char*)smem;
    cg::grid_group grid = cg::this_grid();
    volatile LAS unsigned* bst = (volatile LAS unsigned*)(lds + LDS_BYTES - 64);
    if (threadIdx.x < 2) bst[threadIdx.x] = 0u;
    __syncthreads();
    const XcdBarrier xbar = xcd_barrier_post((unsigned*)(p.ws + WS_BAR), bst);
    unsigned char* ws = p.ws;
    float* ssq = (float*)(ws + WS_SSQ);
    bf16_t* actA = (bf16_t*)(ws + WS_ACTA); bf16_t* big = (bf16_t*)(ws + WS_BIG);
    bf16_t* hb0 = (bf16_t*)p.out; bf16_t* hb1 = hb0 + (size_t)MTOK * DM;
    pg8::StaticOrder S;
    for (int rep = 0; rep < PROBE_PRO; ++rep) prologue(p, lds);
    grid.sync();
    { pg8::Gemm g{actA, (const bf16_t*)(ws + WS_W1GU), MTOK, NGU, DM}; S.init(MTOK, NGU, gridDim.x, blockIdx.x); EpiSwiglu E{big, ssq};
      pg8::gemm_phase<EpiSwiglu, pg8::StaticOrder, true, true>(lds, g, S, E);
      if (PROBE_P1 == 2) { xcd_barrier(xbar); pg8::gemm_phase<EpiSwiglu, pg8::StaticOrder, true, true>(lds, g, S, E); }
      { const int nwg = (MTOK / 256) * (NGU / 256), G = (int)gridDim.x, rem = nwg % G, c = (int)blockIdx.x; const int tid = ltid();
        if (c >= rem) deferred_weights(p, lds, (c - rem) * 8 + (tid >> 6), (G - rem) * 8); } }
    xcd_barrier(xbar);
    { pg8::Gemm g{big, (const bf16_t*)(ws + WS_W1D), MTOK, DM, DFF}; S.init(MTOK, DM, gridDim.x, blockIdx.x); EpiResid<true> E{nullptr, nullptr, 0, actA, hb0, ssq + MTOK, 0.5f};
      pg8::gemm_phase<EpiResid<true>, pg8::StaticOrder, true, true>(lds, g, S, E); }
    xcd_barrier(xbar);
    { pg8::Gemm g{hb0, (const bf16_t*)(ws + WS_WIN), MTOK, 3072, DM}; S.init(MTOK, 3072, gridDim.x, blockIdx.x); EpiZ E{big, ssq + MTOK};
      pg8::gemm_phase<EpiZ, pg8::StaticOrder, true, true>(lds, g, S, E); }
    for (int it = blockIdx.x; it < MTOK / 64; it += gridDim.x) lr_gemm_item(hb0, (const bf16_t*)(ws + WS_WIN) + (size_t)3072 * DM, ssq + MTOK, big, lds, it);
    xcd_barrier(xbar);
    for (int u = blockIdx.x; u < 160 * 8 * PROBE_ATT; u += gridDim.x) attn_unit(p, lds, (u % 1280) >> 3, u & 7, (PROBE_ATT == 2 && u < 1280) ? PROBE_VAR : 0);
    for (int u = blockIdx.x; u < NCHUNK * 4 * PROBE_G1; u += gridDim.x) gla_g1_unit(p, lds, (u % (NCHUNK * 4)) >> 2, u & 3, u + gridDim.x);
    xcd_barrier(xbar);
    gla_g2(p);
    xcd_barrier(xbar);
    for (int u = blockIdx.x; u < NCHUNK * 4 * PROBE_G3; u += gridDim.x) gla_g3_unit(p, lds, (u % (NCHUNK * 4)) >> 2, u & 3, u + gridDim.x);
    xcd_barrier(xbar);
    { pg8::Gemm g{actA, (const bf16_t*)(ws + WS_WOUT), MTOK, DM, DM}; S.init(MTOK, DM, gridDim.x, blockIdx.x); EpiResid<true> E{nullptr, nullptr, 0, hb0, hb1, ssq + 2 * MTOK, 1.0f};
      pg8::gemm_phase<EpiResid<true>, pg8::StaticOrder, true, true>(lds, g, S, E); }
    xcd_barrier(xbar);
    { pg8::Gemm g{hb1, (const bf16_t*)(ws + WS_W2GU), MTOK, NGU, DM}; S.init(MTOK, NGU, gridDim.x, blockIdx.x); EpiSwiglu E{big, ssq + 2 * MTOK};
      pg8::gemm_phase<EpiSwiglu, pg8::StaticOrder, true, true>(lds, g, S, E); }
    xcd_barrier(xbar);
    { pg8::Gemm g{big, (const bf16_t*)(ws + WS_W2D), MTOK, DM, DFF}; S.init(MTOK, DM, gridDim.x, blockIdx.x); EpiResid<true> E{nullptr, nullptr, 0, hb1, actA, ssq + 3 * MTOK, 0.5f};
      pg8::gemm_phase<EpiResid<true>, pg8::StaticOrder, true, true>(lds, g, S, E); }
    xcd_barrier(xbar);
    { const int tid = ltid(), lane = tid & 63, wave = tid >> 6; const int gw = blockIdx.x * 8 + wave, NGW = gridDim.x * 8; const float* gf = p.in[18];
      f32x4 gv[4];
#pragma unroll
      for (int j = 0; j < 4; ++j) gv[j] = ((const f32x4*)gf)[2 * lane + (j & 1) + 128 * (j >> 1)];
      for (int row = gw; row < MTOK; row += 2 * NGW) {
          const int row2 = row + NGW < MTOK ? row + NGW : row;
          const u32x4 a0 = ((const u32x4*)(actA + (size_t)row * DM))[lane], a1 = ((const u32x4*)(actA + (size_t)row * DM))[lane + 64];
          const u32x4 b0 = ((const u32x4*)(actA + (size_t)row2 * DM))[lane], b1 = ((const u32x4*)(actA + (size_t)row2 * DM))[lane + 64];
          const float rs = rsqrtf(ssq[3 * MTOK + row] * (1.0f / DM) + EPS), rs2 = rsqrtf(ssq[3 * MTOK + row2] * (1.0f / DM) + EPS);
#define P10_OUT(rw, scale, q0, q1) do { f32x4* o = (f32x4*)(p.out + (size_t)(rw) * DM); \
          o[2 * lane] = (f32x4){__uint_as_float(q0.x << 16), __uint_as_float(q0.x & 0xffff0000u), __uint_as_float(q0.y << 16), __uint_as_float(q0.y & 0xffff0000u)} * (scale) * gv[0]; \
          o[2 * lane + 1] = (f32x4){__uint_as_float(q0.z << 16), __uint_as_float(q0.z & 0xffff0000u), __uint_as_float(q0.w << 16), __uint_as_float(q0.w & 0xffff0000u)} * (scale) * gv[1]; \
          o[128 + 2 * lane] = (f32x4){__uint_as_float(q1.x << 16), __uint_as_float(q1.x & 0xffff0000u), __uint_as_float(q1.y << 16), __uint_as_float(q1.y & 0xffff0000u)} * (scale) * gv[2]; \
          o[128 + 2 * lane + 1] = (f32x4){__uint_as_float(q1.z << 16), __uint_as_float(q1.z & 0xffff0000u), __uint_as_float(q1.w << 16), __uint_as_float(q1.w & 0xffff0000u)} * (scale) * gv[3]; } while (0)
          P10_OUT(row, rs, a0, a1);
          if (row2 != row) P10_OUT(row2, rs2, b0, b1);
#undef P10_OUT
      } }
}

extern "C" void kernel_launch(void* const* d_in, const int* in_sizes, int n_in, void* d_out, int out_size, void* d_ws, size_t ws_size, hipStream_t stream) {
    static int grid = 0;
    if (grid == 0) {
        if (n_in != 19 || out_size != MTOK * DM || ws_size < WS_END) { fprintf(stderr, "kernel_launch: unexpected shapes (n_in %d out %d ws %zu)\n", n_in, out_size, ws_size); grid = -1; return; }
        int dev = 0, cus = 0, per_cu = 0;
        hipGetDevice(&dev); hipDeviceGetAttribute(&cus, hipDeviceAttributeMultiprocessorCount, dev);
        if (hipFuncSetAttribute((const void*)hymba_fwd, hipFuncAttributeMaxDynamicSharedMemorySize, LDS_BYTES) != hipSuccess) { fprintf(stderr, "kernel_launch: hipFuncSetAttribute failed\n"); grid = -1; return; }
        if (hipOccupancyMaxActiveBlocksPerMultiprocessor(&per_cu, (const void*)hymba_fwd, NTHREADS, LDS_BYTES) != hipSuccess || per_cu < 1) { fprintf(stderr, "kernel_launch: occupancy query gave %d\n", per_cu); per_cu = 1; }
        (void)hipGetLastError();
        grid = cus * 1;
    }
    if (grid < 0) return;
    if (hipMemsetAsync((char*)d_ws + WS_BAR, 0, XCD_BAR_WORDS * 4, stream) != hipSuccess) { fprintf(stderr, "kernel_launch: memset of the barrier words failed\n"); return; }
    Params p{};
    for (int i = 0; i < 19; ++i) p.in[i] = (const float*)d_in[i];
    p.out = (float*)d_out; p.ws = (unsigned char*)d_ws;
    void* args[] = {&p};
    hipError_t e = hipLaunchCooperativeKernel((const void*)hymba_fwd, dim3(grid), dim3(NTHREADS), args, LDS_BYTES, stream);
    if (e != hipSuccess) fprintf(stderr, "cooperative launch failed: %s (grid %d)\n", hipGetErrorString(e), grid);
}
```

```cpp
#include <hip/hip_runtime.h>
#include <hip/hip_cooperative_groups.h>
#include <cstdio>
#include <cstdint>
namespace cg = cooperative_groups;
#define PROBE_ATT 1
#define PROBE_G1 1
#define PROBE_G3 1
#define PROBE_PRO 1
#define PROBE_VAR 1
#define PROBE_P1 1
#define ATT_TOUCH 0
#define GLA_TOUCH 0
namespace pg8 {
#define PG8_LAS __attribute__((address_space(3)))
typedef unsigned short bf16_t;
typedef short bf16x8 __attribute__((ext_vector_type(8)));
typedef float f32x4 __attribute__((ext_vector_type(4)));
typedef unsigned u32x4 __attribute__((ext_vector_type(4)));
constexpr int BM = 256, BK = 64, HALF = 128, HTB = HALF * BK * 2  , STAGE_BYTES = 8 * HTB, NXCD = 8, WGM = 8;

__host__ __device__ __forceinline__ int lds_byte(int r, int c) { const int st = (r >> 4) * 2 + (c >> 5), rr = r & 15, cc = c & 31, ob = rr * 64 + cc * 2; return st * 1024 + (ob ^ (((ob >> 9) & 1) << 5)); }
__host__ __device__ __forceinline__ void stage_rc(int b, int& R, int& C) { const int st = b / 1024, sb = b % 1024, swz = sb ^ (((sb >> 9) & 1) << 5); R = (st >> 1) * 16 + swz / 64; C = (st & 1) * 32 + (swz % 64) / 2; }
__host__ __device__ __forceinline__ int perm32(int rho) { const int n = rho >> 4, i = rho & 15; return 8 * (i >> 2) + 4 * n + (i & 3); }

struct Unit { int pm, pn; };
struct Gemm { const bf16_t* A; const bf16_t* Bt; int M, N, K; };

struct StaticOrder {
    int nM, nN, nwg, G, c;
    __host__ __device__ void init(int M, int N, int G_, int c_) { nM = M / BM; nN = N / BM; nwg = nM * nN; G = G_; c = c_; }
    __host__ __device__ bool next(int i, Unit& u) const {
        const long L = (long)i * G + c; if (L >= nwg) return false;
        int wgid = (int)L; { const int q = nwg / NXCD, r = nwg % NXCD, xcd = wgid % NXCD, off = wgid / NXCD; wgid = (xcd < r ? xcd * (q + 1) : r * (q + 1) + (xcd - r) * q) + off; }
        const int nig = WGM * nN, gid = wgid / nig, fm = gid * WGM, gsz = (nM - fm) < WGM ? (nM - fm) : WGM;
        u.pm = fm + ((wgid % nig) % gsz); u.pn = (wgid % nig) / gsz; return true;
    }
    __device__ __forceinline__ void a_ready(const Unit&) const {}
    __device__ __forceinline__ void done(const Unit&) const {}
};
typedef __bf16 bf16x2_hw __attribute__((ext_vector_type(2)));
__device__ __forceinline__ unsigned cvt_pk_bf16(float lo, float hi) { bf16x2_hw v; v[0] = (__bf16)lo; v[1] = (__bf16)hi; return __builtin_bit_cast(unsigned, v); }
template <class Epi, class Sched, bool ALIGN_EPI = false, bool SP2 = false>
__device__ __forceinline__ void gemm_phase(PG8_LAS unsigned char* lds, const Gemm g, const Sched& S, const Epi& E) {
    const int tid = threadIdx.x, wid = __builtin_amdgcn_readfirstlane(tid >> 6), lane = tid & 63, wr = wid >> 2, wc = wid & 3, fr = lane & 15, fq = lane >> 4;
    const int K = g.K, nt = K / BK;
    unsigned voffA[2], voffB[2];
#pragma unroll
    for (int i = 0; i < 2; ++i) { int R, C; stage_rc(tid * 16 + i * 8192, R, C); const int Rb = Epi::PERM ? ((R & ~31) + perm32(R & 31)) : R;
        voffA[i] = (unsigned)(R * K + C) * 2u; voffB[i] = (unsigned)(Rb * K + C) * 2u; }
    const size_t kstep = (size_t)(BK * 2);
    const size_t hstep = (size_t)HALF * K * 2;
    const size_t tstep = 2 * hstep;
    const unsigned ldsw = (unsigned)wid * 1024u;
    const int aoff = lds_byte(wr * 64 + fr, fq * 8), boff = lds_byte(wc * 32 + fr, fq * 8);
#define PG8_SA(b, h) (((b) * 2 + (h)) * HTB)
#define PG8_SB(b, h) ((4 + (b) * 2 + (h)) * HTB)
#define PG8_STAGE(bufoff, gbase, voff) do { _Pragma("unroll") for (int _i = 0; _i < 2; ++_i) \
        __builtin_amdgcn_global_load_lds((const unsigned*)((const char*)(gbase) + (voff)[_i]), (PG8_LAS unsigned*)(lds + (bufoff) + ldsw + _i * 8192), 16, 0, 0); } while (0)
#define PG8_LDA(dst, b, h) do { _Pragma("unroll") for (int m = 0; m < 4; ++m) _Pragma("unroll") for (int k = 0; k < 2; ++k) dst[m][k] = *(const PG8_LAS bf16x8*)(lds + PG8_SA(b, h) + aoff + m * 2048 + k * 1024); } while (0)
#define PG8_LDB(dst, b, h) do { _Pragma("unroll") for (int n = 0; n < 2; ++n) _Pragma("unroll") for (int k = 0; k < 2; ++k) dst[n][k] = *(const PG8_LAS bf16x8*)(lds + PG8_SB(b, h) + boff + n * 2048 + k * 1024); } while (0)
#define PG8_MMA(ai, bj, At, Bt) do { __builtin_amdgcn_s_setprio(1); _Pragma("unroll") for (int m = 0; m < 4; ++m) _Pragma("unroll") for (int n = 0; n < 2; ++n) _Pragma("unroll") for (int k = 0; k < 2; ++k) \
        acc[ai][bj][m][n] = __builtin_amdgcn_mfma_f32_16x16x32_bf16(Bt[n][k], At[m][k], acc[ai][bj][m][n], 0, 0, 0); __builtin_amdgcn_s_setprio(0); } while (0)
#define PG8_WAIT_V(n) asm volatile("s_waitcnt vmcnt(" #n ")" ::: "memory")
#define PG8_WAIT_L(n) asm volatile("s_waitcnt lgkmcnt(" #n ")" ::: "memory")
#define PG8_BAR __builtin_amdgcn_s_barrier()
#define PG8_SCHED __builtin_amdgcn_sched_barrier(0)
    Unit cur, nxt; int ui = 0;
    if (!S.next(0, cur)) return;
    f32x4 acc[2][2][4][2];
#pragma unroll
    for (int a = 0; a < 2; ++a)
#pragma unroll
        for (int b = 0; b < 2; ++b)
#pragma unroll
            for (int m = 0; m < 4; ++m)
#pragma unroll
                for (int n = 0; n < 2; ++n) acc[a][b][m][n] = (f32x4){0.f, 0.f, 0.f, 0.f};
    bf16x8 At[4][2], B0[2][2], B1[2][2];
    const char* cA = (const char*)g.A + (size_t)cur.pm * tstep; const char* cB = (const char*)g.Bt + (size_t)cur.pn * tstep;
    S.a_ready(cur);
    if constexpr (SP2) {
        PG8_STAGE(PG8_SB(0, 0), cB, voffB); PG8_STAGE(PG8_SB(0, 1), cB + hstep, voffB); PG8_STAGE(PG8_SA(0, 0), cA, voffA); PG8_STAGE(PG8_SA(0, 1), cA + hstep, voffA);
        if (wr == 1) PG8_BAR;
        PG8_WAIT_V(2); PG8_BAR;
        PG8_STAGE(PG8_SB(1, 0), cB + kstep, voffB); PG8_STAGE(PG8_SA(1, 0), cA + kstep, voffA); PG8_STAGE(PG8_SB(1, 1), cB + hstep + kstep, voffB);
        PG8_WAIT_V(6); PG8_BAR;
    } else {
        PG8_STAGE(PG8_SB(0, 0), cB, voffB); PG8_STAGE(PG8_SA(0, 0), cA, voffA); PG8_STAGE(PG8_SB(0, 1), cB + hstep, voffB); PG8_STAGE(PG8_SA(0, 1), cA + hstep, voffA);
        if (wr == 1) PG8_BAR;
        PG8_WAIT_V(4); PG8_BAR;
        PG8_STAGE(PG8_SB(1, 0), cB + kstep, voffB); PG8_STAGE(PG8_SA(1, 0), cA + kstep, voffA); PG8_STAGE(PG8_SB(1, 1), cB + hstep + kstep, voffB);
        PG8_WAIT_V(6); PG8_BAR;
    }
    for (;;) {
        const bool has_next = S.next(ui + 1, nxt);
        const char* nA = has_next ? (const char*)g.A + (size_t)nxt.pm * tstep : cA; const char* nB = has_next ? (const char*)g.Bt + (size_t)nxt.pn * tstep : cB;
        for (int t = 0; t < nt; t += 2) {
            const bool last = (t == nt - 2);
            const char* a1 = cA + (size_t)(t + 1) * kstep;
            const char* a2 = last ? nA : cA + (size_t)(t + 2) * kstep; const char* b2 = last ? nB : cB + (size_t)(t + 2) * kstep;
            const char* a3 = a2 + kstep; const char* b3 = b2 + kstep;
            if (last && has_next) S.a_ready(nxt);
            if constexpr (SP2) {
            PG8_LDB(B0, 0, 0); PG8_LDB(B1, 0, 1); PG8_SCHED; PG8_LDA(At, 0, 0); PG8_STAGE(PG8_SA(1, 1), a1 + hstep, voffA);
            PG8_WAIT_V(8); PG8_WAIT_L(0); PG8_BAR; PG8_MMA(0, 0, At, B0); PG8_MMA(0, 1, At, B1); PG8_BAR; PG8_SCHED;
            PG8_LDA(At, 0, 1); PG8_STAGE(PG8_SB(0, 0), b2, voffB); PG8_STAGE(PG8_SB(0, 1), b2 + hstep, voffB); PG8_STAGE(PG8_SA(0, 0), a2, voffA);
            PG8_WAIT_V(8); PG8_WAIT_L(0); PG8_BAR; PG8_MMA(1, 0, At, B0); PG8_MMA(1, 1, At, B1); PG8_BAR; PG8_SCHED;
            PG8_LDB(B0, 1, 0); PG8_LDB(B1, 1, 1); PG8_SCHED; PG8_LDA(At, 1, 0); PG8_STAGE(PG8_SA(0, 1), a2 + hstep, voffA);
            PG8_WAIT_V(8); PG8_WAIT_L(0); PG8_BAR; PG8_MMA(0, 0, At, B0); PG8_MMA(0, 1, At, B1); PG8_BAR; PG8_SCHED;
            PG8_LDA(At, 1, 1); PG8_STAGE(PG8_SB(1, 0), b3, voffB); PG8_STAGE(PG8_SB(1, 1), b3 + hstep, voffB); PG8_STAGE(PG8_SA(1, 0), a3, voffA);
            PG8_WAIT_V(8); PG8_WAIT_L(0); PG8_BAR; PG8_MMA(1, 0, At, B0); PG8_MMA(1, 1, At, B1); PG8_BAR; PG8_SCHED;
            } else {
            PG8_LDB(B0, 0, 0); PG8_SCHED; PG8_LDA(At, 0, 0); PG8_STAGE(PG8_SA(1, 1), a1 + hstep, voffA);
            PG8_WAIT_L(8); PG8_BAR; PG8_WAIT_L(0); PG8_MMA(0, 0, At, B0); PG8_BAR; PG8_SCHED;
            PG8_LDB(B1, 0, 1); PG8_STAGE(PG8_SB(0, 0), b2, voffB);
            PG8_BAR; PG8_WAIT_L(0); PG8_MMA(0, 1, At, B1); PG8_BAR;
            PG8_LDA(At, 0, 1); PG8_STAGE(PG8_SA(0, 0), a2, voffA);
            PG8_BAR; PG8_WAIT_L(0); PG8_MMA(1, 0, At, B0); PG8_BAR; PG8_SCHED;
            PG8_STAGE(PG8_SB(0, 1), b2 + hstep, voffB);
            PG8_WAIT_V(6); PG8_BAR; PG8_MMA(1, 1, At, B1); PG8_BAR;
            PG8_LDB(B0, 1, 0); PG8_SCHED; PG8_LDA(At, 1, 0); PG8_STAGE(PG8_SA(0, 1), a2 + hstep, voffA);
            PG8_WAIT_L(8); PG8_BAR; PG8_WAIT_L(0); PG8_MMA(0, 0, At, B0); PG8_BAR; PG8_SCHED;
            PG8_LDB(B1, 1, 1); PG8_STAGE(PG8_SB(1, 0), b3, voffB);
            PG8_BAR; PG8_WAIT_L(0); PG8_MMA(0, 1, At, B1); PG8_BAR;
            PG8_LDA(At, 1, 1); PG8_STAGE(PG8_SA(1, 0), a3, voffA);
            PG8_BAR; PG8_WAIT_L(0); PG8_MMA(1, 0, At, B0); PG8_BAR; PG8_SCHED;
            PG8_STAGE(PG8_SB(1, 1), b3 + hstep, voffB);
            PG8_WAIT_V(6); PG8_BAR; PG8_MMA(1, 1, At, B1); PG8_BAR;
            }
        }
        if constexpr (ALIGN_EPI) { if (wr == 0) PG8_BAR; }
        if constexpr (!Epi::AFTER_DRAIN) { E(acc, cur, wr, wc, fr, fq); S.done(cur); }
        if (!has_next) break;
#pragma unroll
        for (int a = 0; a < 2; ++a)
#pragma unroll
            for (int b = 0; b < 2; ++b)
#pragma unroll
                for (int m = 0; m < 4; ++m)
#pragma unroll
                    for (int n = 0; n < 2; ++n) acc[a][b][m][n] = (f32x4){0.f, 0.f, 0.f, 0.f};
        cur = nxt; cA = nA; cB = nB; ++ui;
        if constexpr (ALIGN_EPI) { if (wr == 1) PG8_BAR; }
    }
    PG8_WAIT_V(0);
    if constexpr (!ALIGN_EPI) { if (wr == 0) PG8_BAR; }
    PG8_BAR;
    if constexpr (Epi::AFTER_DRAIN) { E.fused(acc, cur, wr, wc, fr, fq, lds, wid, lane); S.done(cur); }
#undef PG8_SA
#undef PG8_SB
#undef PG8_STAGE
#undef PG8_LDA
#undef PG8_LDB
#undef PG8_MMA
#undef PG8_WAIT_V
#undef PG8_WAIT_L
#undef PG8_BAR
#undef PG8_SCHED
}
}
using pg8::bf16_t; using pg8::bf16x8; using pg8::f32x4; using pg8::u32x4; using pg8::Unit; using pg8::cvt_pk_bf16;
#define LAS __attribute__((address_space(3)))
typedef unsigned u32x2 __attribute__((ext_vector_type(2)));
typedef short s16x4 __attribute__((ext_vector_type(4)));

constexpr int MTOK = 81920, MPROMPT = 65536, DM = 1024, DFF = 2816, NGU = 5632, NZC = 3104  , NZ = 3136  , NZP = 3328;
constexpr int ZQ = 0, ZK = 256, ZV = 512, ZR = 1024, ZAQ = 1536, ZAK = 2048, ZAV = 2560, ZLF = 3072, ZLB = 3088;
constexpr int NCHUNK = 1280;
constexpr float EPS = 1e-6f, LOG2E = 1.4426950408889634f;
constexpr size_t MiB = 1u << 20;
constexpr size_t WS_SSQ = 0, WS_DEC = 2 * MiB, WS_W1GU = 5 * MiB, WS_W1D = 16 * MiB, WS_W2GU = 22 * MiB, WS_W2D = 33 * MiB, WS_WIN = 39 * MiB, WS_WOUT = 46 * MiB,
                 WS_ACTA = 48 * MiB, WS_ST = 208 * MiB, WS_BIG = 368 * MiB, WS_DUMMY = 860 * MiB, WS_BAR = 862 * MiB, WS_END = 863 * MiB;
constexpr int LDS_BYTES = 147456;
constexpr int NTHREADS = 512;

struct Params { const float* in[19]; float* out; unsigned char* ws; };

__device__ __forceinline__ int ltid() { int t = threadIdx.x; asm volatile("" : "+v"(t)); return t; }
__device__ __forceinline__ float bf2f(unsigned short b) { return __uint_as_float((unsigned)b << 16); }
__device__ __forceinline__ unsigned short f2bf(float f) { unsigned u = __float_as_uint(f); return (unsigned short)((u + 0x7fffu + ((u >> 16) & 1u)) >> 16); }
__device__ __forceinline__ float wave_sum(float v) {
#pragma unroll
    for (int o = 1; o < 64; o <<= 1) v += __shfl_xor(v, o);
    return v;
}
__device__ __forceinline__ float quad_max(float x) {
    auto a = __builtin_amdgcn_permlane16_swap(__float_as_uint(x), __float_as_uint(x), false, false); x = fmaxf(__uint_as_float(a[0]), __uint_as_float(a[1]));
    auto b = __builtin_amdgcn_permlane32_swap(__float_as_uint(x), __float_as_uint(x), false, false); return fmaxf(__uint_as_float(b[0]), __uint_as_float(b[1]));
}
__device__ __forceinline__ float quad_sum(float x) {
    auto a = __builtin_amdgcn_permlane16_swap(__float_as_uint(x), __float_as_uint(x), false, false); x = __uint_as_float(a[0]) + __uint_as_float(a[1]);
    auto b = __builtin_amdgcn_permlane32_swap(__float_as_uint(x), __float_as_uint(x), false, false); return __uint_as_float(b[0]) + __uint_as_float(b[1]);
}
__device__ __forceinline__ void lds_barrier() { asm volatile("s_waitcnt lgkmcnt(0)" ::: "memory"); __builtin_amdgcn_s_barrier(); asm volatile("" ::: "memory"); }
#define LDS_WAIT() asm volatile("s_waitcnt lgkmcnt(0)" ::: "memory")

__device__ __forceinline__ void transpose_item(const float* W, int K, int N, bf16_t* WT, int mode, const float* gk, LAS float* scr, int item, int lane) {
    const int nblk = N / 32, kb = item / nblk, nb = item % nblk, k0 = 64 * kb, n0 = 32 * nb;
#pragma unroll 8
    for (int i = 0; i < 32; ++i) { const int kk = 2 * i + (lane >> 5); const float g = gk ? gk[k0 + kk] : 1.0f; scr[kk * 33 + (lane & 31)] = W[(size_t)(k0 + kk) * N + n0 + (lane & 31)] * g; }
    LDS_WAIT(); asm volatile("" ::: "memory");
    const int c = lane & 7;
#pragma unroll
    for (int j = 0; j < 4; ++j) {
        const int n = (lane >> 3) + 8 * j, ns = n0 + n; int drow = ns; float rs = 1.0f;
        if (mode == 1) drow = (ns >> 2) * 8 + (ns & 3);
        else if (mode == 2) drow = (ns >> 2) * 8 + 4 + (ns & 3);
        else if (mode == 3) { drow = ns < 1536 ? ns : (ns < 1568 ? ns + 1536 : ns - 32); if (ns < 256) rs = 0.125f; else if (ns >= 1568 && ns < 2080) rs = 0.125f * LOG2E; }
        const LAS float* s = scr + (8 * c) * 33 + n;
        u32x4 o; o.x = cvt_pk_bf16(s[0 * 33] * rs, s[1 * 33] * rs); o.y = cvt_pk_bf16(s[2 * 33] * rs, s[3 * 33] * rs); o.z = cvt_pk_bf16(s[4 * 33] * rs, s[5 * 33] * rs); o.w = cvt_pk_bf16(s[6 * 33] * rs, s[7 * 33] * rs);
        *(u32x4*)(WT + (size_t)drow * K + k0 + 8 * c) = o;
    }
    LDS_WAIT(); asm volatile("" ::: "memory");
}

__device__ __forceinline__ void prologue(const Params& p, LAS unsigned char* lds) {
    const int tid = ltid(), lane = tid & 63, wave = tid >> 6;
    const int gw = blockIdx.x * 8 + wave, NGW = gridDim.x * 8;
    LAS float* scr = (LAS float*)(lds + wave * 8704);
    unsigned char* ws = p.ws;
    constexpr int I_GU = (DM / 64) * (DFF / 32), I_D = (DFF / 64) * (DM / 32);
    constexpr int NITEMS = 2 * I_GU + I_D;
    for (int it = gw; it < NITEMS; it += NGW) {
        int r = it;
        if (r < I_GU) { transpose_item(p.in[3], DM, DFF, (bf16_t*)(ws + WS_W1GU), 1, p.in[2], scr, r, lane); continue; } r -= I_GU;
        if (r < I_GU) { transpose_item(p.in[4], DM, DFF, (bf16_t*)(ws + WS_W1GU), 2, p.in[2], scr, r, lane); continue; } r -= I_GU;
        transpose_item(p.in[5], DFF, DM, (bf16_t*)(ws + WS_W1D), 0, nullptr, scr, r, lane);
    }
    float* ssq = (float*)(ws + WS_SSQ); bf16_t* xb = (bf16_t*)(ws + WS_ACTA);
    for (int row = gw; row < MTOK; row += 2 * NGW) {
        const int row2 = row + NGW; const bool has2 = row2 < MTOK;
        const float* xr = row < MPROMPT ? p.in[0] + (size_t)row * DM : p.in[1] + (size_t)(row - MPROMPT) * DM;
        const float* xr2 = !has2 ? xr : (row2 < MPROMPT ? p.in[0] + (size_t)row2 * DM : p.in[1] + (size_t)(row2 - MPROMPT) * DM);
        f32x4 v[4], v2[4]; float s = 0.f, s2 = 0.f;
#pragma unroll
        for (int j = 0; j < 4; ++j) { v[j] = ((const f32x4*)xr)[lane + 64 * j]; v2[j] = ((const f32x4*)xr2)[lane + 64 * j]; }
#pragma unroll
        for (int j = 0; j < 4; ++j) { s += (v[j].x * v[j].x + v[j].y * v[j].y) + (v[j].z * v[j].z + v[j].w * v[j].w); s2 += (v2[j].x * v2[j].x + v2[j].y * v2[j].y) + (v2[j].z * v2[j].z + v2[j].w * v2[j].w); }
        s = wave_sum(s); s2 = wave_sum(s2);
#pragma unroll
        for (int j = 0; j < 4; ++j) { u32x2 o; o.x = cvt_pk_bf16(v[j].x, v[j].y); o.y = cvt_pk_bf16(v[j].z, v[j].w); ((u32x2*)(xb + (size_t)row * DM))[lane + 64 * j] = o; }
        if (lane == 0) ssq[row] = s;
        if (has2) {
#pragma unroll
            for (int j = 0; j < 4; ++j) { u32x2 o; o.x = cvt_pk_bf16(v2[j].x, v2[j].y); o.y = cvt_pk_bf16(v2[j].z, v2[j].w); ((u32x2*)(xb + (size_t)row2 * DM))[lane + 64 * j] = o; }
            if (lane == 0) ssq[row2] = s2; }
    }
    const int gt = blockIdx.x * NTHREADS + tid, NGT = gridDim.x * NTHREADS;
    for (int i = gt; i < 3 * MTOK / 4; i += NGT) ((f32x4*)(ssq + MTOK))[i] = (f32x4){0.f, 0.f, 0.f, 0.f};
    u32x4* padp = (u32x4*)((bf16_t*)(ws + WS_WIN) + (size_t)NZC * DM);
    for (int i = gt; i < (NZP - NZC) * DM / 8; i += NGT) padp[i] = (u32x4){0u, 0u, 0u, 0u};
}

__device__ __forceinline__ void deferred_weights(const Params& p, LAS unsigned char* lds, int widx, int nw) {
    const int tid = ltid(), lane = tid & 63, wave = tid >> 6;
    LAS float* scr = (LAS float*)(lds + wave * 8704);
    unsigned char* ws = p.ws;
    constexpr int I_GU = (DM / 64) * (DFF / 32), I_D = (DFF / 64) * (DM / 32), I_IN = (DM / 64) * (NZC / 32), I_OUT = (DM / 64) * (DM / 32);
    constexpr int NITEMS = 2 * I_GU + I_D + I_IN + I_OUT;
    for (int it = widx; it < NITEMS; it += nw) {
        int r = it;
        if (r < I_IN) { transpose_item(p.in[7], DM, NZC, (bf16_t*)(ws + WS_WIN), 3, p.in[6], scr, r, lane); continue; } r -= I_IN;
        if (r < I_OUT) { transpose_item(p.in[13], DM, DM, (bf16_t*)(ws + WS_WOUT), 0, nullptr, scr, r, lane); continue; } r -= I_OUT;
        if (r < I_GU) { transpose_item(p.in[15], DM, DFF, (bf16_t*)(ws + WS_W2GU), 1, p.in[14], scr, r, lane); continue; } r -= I_GU;
        if (r < I_GU) { transpose_item(p.in[16], DM, DFF, (bf16_t*)(ws + WS_W2GU), 2, p.in[14], scr, r, lane); continue; } r -= I_GU;
        transpose_item(p.in[17], DFF, DM, (bf16_t*)(ws + WS_W2D), 0, nullptr, scr, r, lane);
    }
}

__device__ __forceinline__ void lr_gemm_item(const bf16_t* A, const bf16_t* Wt  , const float* ssq, bf16_t* Z, LAS unsigned char* lds, int item) {
    const int tid = ltid(), lane = tid & 63, wave = tid >> 6, fr = lane & 15, quad = lane >> 4; const int row0 = item * 64, k0 = wave * 128 + quad * 8;
    bf16x8 a[4][4], bw[2][4];
#pragma unroll
    for (int rt = 0; rt < 4; ++rt)
#pragma unroll
        for (int ks = 0; ks < 4; ++ks) a[rt][ks] = *(const bf16x8*)(A + (size_t)(row0 + rt * 16 + fr) * DM + k0 + ks * 32);
#pragma unroll
    for (int ct = 0; ct < 2; ++ct)
#pragma unroll
        for (int ks = 0; ks < 4; ++ks) bw[ct][ks] = *(const bf16x8*)(Wt + (size_t)(ct * 16 + fr) * DM + k0 + ks * 32);
    LAS float* part = (LAS float*)lds;
#pragma unroll
    for (int rt = 0; rt < 4; ++rt)
#pragma unroll
        for (int ct = 0; ct < 2; ++ct) { f32x4 acc = {0.f, 0.f, 0.f, 0.f};
#pragma unroll
            for (int ks = 0; ks < 4; ++ks) acc = __builtin_amdgcn_mfma_f32_16x16x32_bf16(a[rt][ks], bw[ct][ks], acc, 0, 0, 0);
#pragma unroll
            for (int j = 0; j < 4; ++j) part[(wave * 64 + rt * 16 + quad * 4 + j) * 32 + ct * 16 + fr] = acc[j]; }
    __syncthreads();
    { const int r = tid >> 3, c4 = (tid & 7) * 4; f32x4 s = {0.f, 0.f, 0.f, 0.f};
#pragma unroll
      for (int w = 0; w < 8; ++w) s += *(const LAS f32x4*)(part + (w * 64 + r) * 32 + c4);
      const float rs = rsqrtf(ssq[row0 + r] * (1.0f / DM) + EPS);
      u32x2 o; o.x = cvt_pk_bf16(s[0] * rs, s[1] * rs); o.y = cvt_pk_bf16(s[2] * rs, s[3] * rs);
      *(u32x2*)(Z + (size_t)(row0 + r) * NZ + ZLF + c4) = o; }
    __syncthreads();
}

struct EpiSwiglu {
    static constexpr bool PERM = true, AFTER_DRAIN = false;
    bf16_t* H; const float* ssq;
    __device__ __forceinline__ void operator()(const f32x4 (&acc)[2][2][4][2], const Unit& u, int wr, int wc, int fr, int fq) const {
        const int row0 = u.pm * 256 + wr * 64 + fr, hc0 = u.pn * 128 + wc * 16 + 4 * fq;
        const int hcs = (fq & 1) ? hc0 + 60 : hc0;
#pragma unroll
        for (int ai = 0; ai < 2; ++ai)
#pragma unroll
            for (int m = 0; m < 4; ++m) {
                const int row = row0 + ai * 128 + m * 16; const float rs = rsqrtf(ssq[row] * (1.0f / DM) + EPS), nrl = -LOG2E * rs, rs2 = rs * rs;
                u32x2 o[2];
#pragma unroll
                for (int bj = 0; bj < 2; ++bj) {
                    const f32x4 ga = acc[ai][bj][m][0], ua = acc[ai][bj][m][1]; float hv[4];
#pragma unroll
                    for (int j = 0; j < 4; ++j) hv[j] = (ga[j] * ua[j]) * (rs2 * __builtin_amdgcn_rcpf(1.0f + __builtin_amdgcn_exp2f(nrl * ga[j])));
                    o[bj].x = cvt_pk_bf16(hv[0], hv[1]); o[bj].y = cvt_pk_bf16(hv[2], hv[3]);
                }
                const auto rx = __builtin_amdgcn_permlane16_swap(o[0].x, o[1].x, false, false), ry = __builtin_amdgcn_permlane16_swap(o[0].y, o[1].y, false, false);
                u32x4 w; w.x = rx[0]; w.y = ry[0]; w.z = rx[1]; w.w = ry[1];
                *(u32x4*)(H + (size_t)row * DFF + hcs) = w;
            }
    }
};
template <bool BASE_BF16> struct EpiResid {
    static constexpr bool PERM = true, AFTER_DRAIN = false;
    const float* base0; const float* base1; int split; const bf16_t* baseb; bf16_t* ob; float* ssq; float alpha;
    __device__ __forceinline__ void operator()(const f32x4 (&acc)[2][2][4][2], const Unit& u, int wr, int wc, int fr, int fq) const {
        const int row0 = u.pm * 256 + wr * 64 + fr, c00 = u.pn * 256 + wc * 32 + 8 * fq;
        float ssum[2][4];
#pragma unroll
        for (int ai = 0; ai < 2; ++ai)
#pragma unroll
            for (int m = 0; m < 4; ++m) {
                const int row = row0 + ai * 128 + m * 16;
                float s = 0.f;
#pragma unroll
                for (int bj = 0; bj < 2; ++bj) {
                    const int c0 = c00 + bj * 128; f32x4 b0, b1;
                    if constexpr (BASE_BF16) { const u32x4 r = *(const u32x4*)(baseb + (size_t)row * DM + c0);
                        b0 = (f32x4){__uint_as_float(r.x << 16), __uint_as_float(r.x & 0xffff0000u), __uint_as_float(r.y << 16), __uint_as_float(r.y & 0xffff0000u)};
                        b1 = (f32x4){__uint_as_float(r.z << 16), __uint_as_float(r.z & 0xffff0000u), __uint_as_float(r.w << 16), __uint_as_float(r.w & 0xffff0000u)};
                    } else { const float* b = row < split ? base0 + (size_t)row * DM : base1 + (size_t)(row - split) * DM; b0 = *(const f32x4*)(b + c0); b1 = *(const f32x4*)(b + c0 + 4); }
                    const f32x4 v0 = b0 + acc[ai][bj][m][0] * alpha, v1 = b1 + acc[ai][bj][m][1] * alpha;
                    u32x4 w; w.x = cvt_pk_bf16(v0[0], v0[1]); w.y = cvt_pk_bf16(v0[2], v0[3]); w.z = cvt_pk_bf16(v1[0], v1[1]); w.w = cvt_pk_bf16(v1[2], v1[3]); *(u32x4*)(ob + (size_t)row * DM + c0) = w;
                    s += (v0[0] * v0[0] + v0[1] * v0[1]) + (v0[2] * v0[2] + v0[3] * v0[3]) + (v1[0] * v1[0] + v1[1] * v1[1]) + (v1[2] * v1[2] + v1[3] * v1[3]);
                }
                ssum[ai][m] = quad_sum(s);
            }
#pragma unroll
        for (int ai = 0; ai < 2; ++ai) { const float v = fq == 0 ? ssum[ai][0] : fq == 1 ? ssum[ai][1] : fq == 2 ? ssum[ai][2] : ssum[ai][3];
            atomicAdd(ssq + row0 + ai * 128 + fq * 16, v); }
    }
};
struct EpiZ {
    static constexpr bool PERM = true, AFTER_DRAIN = false;
    bf16_t* Z; const float* ssq;
    __device__ __forceinline__ void operator()(const f32x4 (&acc)[2][2][4][2], const Unit& u, int wr, int wc, int fr, int fq) const {
        const int row0 = u.pm * 256 + wr * 64 + fr, c00 = u.pn * 256 + wc * 32 + 8 * fq;
#pragma unroll
        for (int ai = 0; ai < 2; ++ai)
#pragma unroll
            for (int m = 0; m < 4; ++m) {
                const int row = row0 + ai * 128 + m * 16; const float rs = rsqrtf(ssq[row] * (1.0f / DM) + EPS);
#pragma unroll
                for (int bj = 0; bj < 2; ++bj) {
                    const int c0 = c00 + bj * 128;
                    { const f32x4 v0 = acc[ai][bj][m][0] * rs, v1 = acc[ai][bj][m][1] * rs;
                        u32x4 w; w.x = cvt_pk_bf16(v0[0], v0[1]); w.y = cvt_pk_bf16(v0[2], v0[3]); w.z = cvt_pk_bf16(v1[0], v1[1]); w.w = cvt_pk_bf16(v1[2], v1[3]);
                        *(u32x4*)(Z + (size_t)row * NZ + c0) = w; }
                }
            }
    }
};
#define XB_TMO      128
#define XB_XCNT(j)  (256  + 64 * (j))
#define XB_XSUB(j)  (1280 + 64 * (j))
#define XB_XGEN(j)  (2304 + 64 * (j))
#define XB_TOP      3328
#define XB_TOPGEN   3392
#define XCD_BAR_WORDS 3456
#define XB_SPIN_CAP (1u << 18)

__device__ __forceinline__ unsigned xb_ld(unsigned* p)              { return __hip_atomic_load(p, __ATOMIC_RELAXED, __HIP_MEMORY_SCOPE_AGENT); }
__device__ __forceinline__ unsigned xb_add(unsigned* p, unsigned v) { return __hip_atomic_fetch_add(p, v, __ATOMIC_RELAXED, __HIP_MEMORY_SCOPE_AGENT); }
__device__ __forceinline__ unsigned xb_xcc_id() { return (unsigned)__builtin_amdgcn_s_getreg((3 << 11) | 20) & 0xFu; }
#define XB_SPIN(cond, bar) do { unsigned _sp = 0; while (cond) { __builtin_amdgcn_s_sleep(1); \
    if ((++_sp & 255u) == 0u) { if (xb_ld(&(bar)[XB_TMO])) break; if (_sp > XB_SPIN_CAP) { atomicAdd(&(bar)[XB_TMO], 1u); break; } } } } while (0)

struct XcdBarrier {
    unsigned* bar; unsigned x;
    volatile LAS unsigned* st;
};

__device__ __forceinline__ XcdBarrier xcd_barrier_post(unsigned* bar, volatile LAS unsigned* st) {
    XcdBarrier b; b.bar = bar; b.x = xb_xcc_id(); b.st = st;
    if (threadIdx.x == 0) (void)xb_add(&bar[XB_XCNT(b.x)], 1u);
    return b;
}
__device__ __forceinline__ void xcd_barrier_complete(unsigned* bar, unsigned x, unsigned& nloc, unsigned& nx) {
    const unsigned G = gridDim.x * gridDim.y * gridDim.z;
    unsigned sum, cnt, mine, sp = 0u;
    for (;;) {
        sum = 0u; cnt = 0u; mine = 0u;
#pragma unroll
        for (unsigned j = 0; j < 16; ++j) { const unsigned c = xb_ld(&bar[XB_XCNT(j)]); sum += c; cnt += (c > 0u) ? 1u : 0u; mine = (j == x) ? c : mine; }
        if (sum == G) break;
        __builtin_amdgcn_s_sleep(1);
        if ((++sp & 255u) == 0u) { if (xb_ld(&bar[XB_TMO])) break; if (sp > XB_SPIN_CAP) { atomicAdd(&bar[XB_TMO], 1u); break; } }
    }
    nloc = mine > 0u ? mine : 1u; nx = cnt > 0u ? cnt : 1u;
}

__device__ __forceinline__ void xcd_barrier(const XcdBarrier& b) {
    asm volatile("s_waitcnt vmcnt(0)" ::: "memory");
    __syncthreads();
    if (threadIdx.x == 0) {
        unsigned* bar = b.bar;
        __builtin_amdgcn_s_waitcnt(0);
        unsigned nloc = b.st[0], nx = b.st[1];
        if (nloc == 0u) { xcd_barrier_complete(bar, b.x, nloc, nx); b.st[0] = nloc; b.st[1] = nx; }
        const unsigned old = xb_add(&bar[XB_XSUB(b.x)], 1u);
        const unsigned gen = old / nloc;
        if (old + 1u == (gen + 1u) * nloc) {
            __builtin_amdgcn_fence(__ATOMIC_RELEASE, "agent");
            asm volatile("s_waitcnt vmcnt(0)" ::: "memory");
            const unsigned og = xb_add(&bar[XB_TOP], 1u);
            const unsigned tg = og / nx;
            if (og + 1u == (tg + 1u) * nx) xb_add(&bar[XB_TOPGEN], 1u);
            else XB_SPIN(xb_ld(&bar[XB_TOPGEN]) == tg, bar);
            __builtin_amdgcn_fence(__ATOMIC_ACQUIRE, "agent");
            xb_add(&bar[XB_XGEN(b.x)], 1u);
            asm volatile("s_waitcnt vmcnt(0)" ::: "memory");
        } else {
            XB_SPIN(xb_ld(&bar[XB_XGEN(b.x)]) == gen, bar);
            __builtin_amdgcn_fence(__ATOMIC_ACQUIRE, "agent");
            asm volatile("s_waitcnt vmcnt(0)" ::: "memory");
        }
    }
    __syncthreads();
}

#define MFMA16(a, b, c) __builtin_amdgcn_mfma_f32_16x16x32_bf16((a), (b), (c), 0, 0, 0)
typedef __bf16 bf2_t __attribute__((ext_vector_type(2)));
__device__ __forceinline__ float dot2bf(unsigned a, unsigned b, float c) { return __builtin_amdgcn_fdot2_f32_bf16(__builtin_bit_cast(bf2_t, a), __builtin_bit_cast(bf2_t, b), c, false); }
__device__ __forceinline__ bf16_t f2bf1(float x) { return (bf16_t)cvt_pk_bf16(x, 0.f); }
constexpr int GL_LR = 0  , GL_WA = 8192, GL_BA = 16384, GL_TOT = 16896, GL_VT = 18944  , GL_A = 37376  , GL_P = 74240  , GL_SS = 83456  , GL_KR = 85504  , GL_QR = 94720  ;

__device__ __forceinline__ void gla_load(const Params& p, const bf16_t* Z, LAS unsigned char* lds, int gc, int h, bool withq) {
    const int tid = ltid(); const size_t tok0 = (size_t)gc * 64;
    LAS unsigned* lr = (LAS unsigned*)(lds + GL_LR); LAS float* wa = (LAS float*)(lds + GL_WA); LAS float* ba = (LAS float*)(lds + GL_BA); LAS bf16_t* vT = (LAS bf16_t*)(lds + GL_VT);
    { const int t = tid >> 3, r4 = (tid & 7) * 4; const u32x2 raw = *(const u32x2*)(Z + (tok0 + t) * NZ + ZLF + r4);
      *(LAS u32x2*)(lr + ((r4 >> 4) * 64 + t) * 8 + ((r4 & 15) >> 1)) = raw; }
    { const int dir = tid >> 8, r = (tid >> 4) & 15, kk4 = (tid & 15) * 4; const float* src = (dir ? p.in[10] : p.in[8]) + r * 256 + h * 64 + kk4;
      *(LAS f32x4*)(wa + (dir * 16 + r) * 64 + kk4) = *(const f32x4*)src; }
    { const int t = tid >> 3, k8 = (tid & 7) * 8;
      *(LAS u32x4*)(lds + GL_KR + (t * 72 + k8) * 2) = *(const u32x4*)(Z + (tok0 + t) * NZ + ZK + h * 64 + k8);
      if (withq) *(LAS u32x4*)(lds + GL_QR + (t * 72 + k8) * 2) = *(const u32x4*)(Z + (tok0 + t) * NZ + ZQ + h * 64 + k8); }
    if (tid < 128) { const int dir = tid >> 6, kk = tid & 63; ba[dir * 64 + kk] = (dir ? p.in[11] : p.in[9])[h * 64 + kk]; }
    { const int t = tid >> 3, dv0 = (tid & 7) * 16; const u32x4* src = (const u32x4*)(Z + (tok0 + t) * NZ + ZV + h * 128 + dv0); const u32x4 a = src[0], b = src[1];
      const unsigned wv[8] = {a.x, a.y, a.z, a.w, b.x, b.y, b.z, b.w};
#pragma unroll
      for (int e = 0; e < 8; ++e) { vT[(dv0 + 2 * e) * 72 + t] = (bf16_t)(wv[e] & 0xffffu); vT[(dv0 + 2 * e + 1) * 72 + t] = (bf16_t)(wv[e] >> 16); } }
    __syncthreads();
}
__device__ __forceinline__ void gla_gates(LAS unsigned char* lds, float (&c)[16], float (&la)[16], float& off, float& all) {
    const int tid = ltid(), dir = tid >> 8, qtr = (tid >> 6) & 3, kk = tid & 63;
    LAS unsigned* lr = (LAS unsigned*)(lds + GL_LR); LAS float* wa = (LAS float*)(lds + GL_WA); LAS float* ba = (LAS float*)(lds + GL_BA); LAS float* tot = (LAS float*)(lds + GL_TOT);
    unsigned w2[8];
#pragma unroll
    for (int r = 0; r < 8; ++r) w2[r] = cvt_pk_bf16(wa[(dir * 16 + 2 * r) * 64 + kk], wa[(dir * 16 + 2 * r + 1) * 64 + kk]);
    const float bias = ba[dir * 64 + kk]; float run = 0.f;
#pragma unroll
    for (int gb = 0; gb < 2; ++gb) {
        u32x4 L[8][2];
#pragma unroll
        for (int i = 0; i < 8; ++i) { const LAS u32x4* l4 = (const LAS u32x4*)(lr + (dir * 64 + qtr * 16 + gb * 8 + i) * 8); L[i][0] = l4[0]; L[i][1] = l4[1]; }
        asm volatile("s_waitcnt lgkmcnt(0)" ::: "memory");
#pragma unroll
        for (int i = 0; i < 8; ++i) { const u32x4 v0 = L[i][0], v1 = L[i][1];
            float x = bias, y = 0.f;
            x = dot2bf(v0.x, w2[0], x); y = dot2bf(v0.y, w2[1], y); x = dot2bf(v0.z, w2[2], x); y = dot2bf(v0.w, w2[3], y);
            x = dot2bf(v1.x, w2[4], x); y = dot2bf(v1.y, w2[5], y); x = dot2bf(v1.z, w2[6], x); y = dot2bf(v1.w, w2[7], y);
            x += y;
            const float li = -(fmaxf(-x, 0.f) + 0.6931471805599453f * __builtin_amdgcn_logf(1.0f + __builtin_amdgcn_exp2f(-LOG2E * fabsf(x)))) * (1.0f / 16.0f);
            run += li; c[gb * 8 + i] = run; la[gb * 8 + i] = li; }
    }
    tot[(dir * 4 + qtr) * 64 + kk] = run;
    lds_barrier();
    off = 0.f; all = 0.f;
#pragma unroll
    for (int q = 0; q < 4; ++q) { const float v = tot[(dir * 4 + q) * 64 + kk]; all += v; if (q < qtr) off += v; }
}

__device__ __forceinline__ unsigned gla_touch(const Params& p, int un, bool states) {
    const bf16_t* Z = (const bf16_t*)(p.ws + WS_BIG); const int tid = ltid(); unsigned r = 0u;
    if (GLA_TOUCH && un < NCHUNK * 4) { const int gc = un >> 2, h = un & 3;
        if (tid < 448) { const int t = tid & 63, w = tid >> 6; const int col = w == 0 ? ZQ + h * 64 : w == 1 ? ZK + h * 64 : w == 2 ? ZV + h * 128 : w == 3 ? ZV + h * 128 + 64 : w == 4 ? ZR + h * 128 : w == 5 ? ZR + h * 128 + 64 : ZLF;
            r = *(const unsigned*)(Z + ((size_t)gc * 64 + t) * NZ + col); }
        if (states && tid < 256) r ^= *(const unsigned*)((const bf16_t*)(p.ws + WS_ST) + (size_t)(gc * 4 + h) * 2 * 8192 + tid * 64); }
    return r;
}
__device__ __forceinline__ void gla_g1_unit(const Params& p, LAS unsigned char* lds, int gc, int h, int un) {
    const bf16_t* Z = (const bf16_t*)(p.ws + WS_BIG); bf16_t* ST = (bf16_t*)(p.ws + WS_ST); float* DEC = (float*)(p.ws + WS_DEC);
    const int tid = ltid(), lane = tid & 63, wave = tid >> 6, dir = tid >> 8, qtr = (tid >> 6) & 3, kk = tid & 63; const size_t tok0 = (size_t)gc * 64;
    gla_load(p, Z, lds, gc, h, false);
    const LAS bf16_t* kraw = (const LAS bf16_t*)(lds + GL_KR) + (qtr * 16) * 72 + kk;
    float c[16], la[16], off, all; gla_gates(lds, c, la, off, all);
    LAS bf16_t* KeT = (LAS bf16_t*)(lds + GL_A);
#pragma unroll
    for (int i = 0; i < 16; ++i) { const int t = qtr * 16 + i; const float e = __builtin_amdgcn_exp2f(LOG2E * (dir == 0 ? all - (off + c[i]) : off + c[i] - la[i]));
        KeT[(dir * 64 + kk) * 72 + t] = f2bf1(bf2f(kraw[i * 72]) * e); }
    if (qtr == 0) DEC[((size_t)(gc * 4 + h) * 2 + dir) * 64 + kk] = __builtin_amdgcn_exp2f(LOG2E * all);
    lds_barrier();
    { const LAS bf16_t* vT = (const LAS bf16_t*)(lds + GL_VT); const int wd = wave >> 2, wq = wave & 3, fr = lane & 15, quad = lane >> 4;
      bf16_t* dst = ST + ((size_t)(gc * 4 + h) * 2 + wd) * 8192;
#pragma unroll
      for (int dd = 0; dd < 2; ++dd) { const int dvt = 2 * wq + dd; bf16x8 b[2];
#pragma unroll
        for (int ks = 0; ks < 2; ++ks) b[ks] = *(const LAS bf16x8*)(vT + (dvt * 16 + fr) * 72 + ks * 32 + quad * 8);
#pragma unroll
        for (int kp = 0; kp < 2; ++kp) { u32x2 o[2];
#pragma unroll
          for (int kq = 0; kq < 2; ++kq) { const int kt = 2 * kp + kq; f32x4 acc = {0.f, 0.f, 0.f, 0.f};
#pragma unroll
            for (int ks = 0; ks < 2; ++ks) { const bf16x8 a = *(const LAS bf16x8*)(KeT + (wd * 64 + kt * 16 + fr) * 72 + ks * 32 + quad * 8); acc = MFMA16(a, b[ks], acc); }
            o[kq].x = cvt_pk_bf16(acc[0], acc[1]); o[kq].y = cvt_pk_bf16(acc[2], acc[3]); }
          const auto rx = __builtin_amdgcn_permlane16_swap(o[0].x, o[1].x, false, false), ry = __builtin_amdgcn_permlane16_swap(o[0].y, o[1].y, false, false);
          u32x4 w; w.x = rx[0]; w.y = ry[0]; w.z = rx[1]; w.w = ry[1];
          const int ko = (quad & 1) ? (2 * kp + 1) * 16 + (quad - 1) * 4 : (2 * kp) * 16 + quad * 4;
          *(u32x4*)(dst + (dvt * 16 + fr) * 64 + ko) = w; } } }
    lds_barrier();
}

template <int EL, int NB> __device__ __forceinline__ void g2_scan(bf16_t* ST, const float* DEC, int c0, int n, int h, int dir, int eo) {
    const int k0 = eo & 63;
    float S[EL];
#pragma unroll
    for (int e = 0; e < EL; ++e) S[e] = 0.f;
    for (int i0 = 0; i0 < n; i0 += NB) {
        unsigned kv[NB][EL / 2]; float d[NB][EL];
#pragma unroll
        for (int u = 0; u < NB; ++u) { const int i = i0 + u, c = dir == 0 ? c0 + i : c0 + n - 1 - i; const size_t slot = (size_t)(c * 4 + h) * 2 + dir;
            if constexpr (EL == 8) { const u32x4 t = *(const u32x4*)(ST + slot * 8192 + eo); kv[u][0] = t.x; kv[u][1] = t.y; kv[u][2] = t.z; kv[u][3] = t.w; }
            else { const u32x2 t = *(const u32x2*)(ST + slot * 8192 + eo); kv[u][0] = t.x; kv[u][1] = t.y; }
#pragma unroll
            for (int q = 0; q < EL / 4; ++q) { const f32x4 t = *(const f32x4*)(DEC + slot * 64 + k0 + 4 * q); d[u][4 * q] = t[0]; d[u][4 * q + 1] = t[1]; d[u][4 * q + 2] = t[2]; d[u][4 * q + 3] = t[3]; } }
#pragma unroll
        for (int u = 0; u < NB; ++u) {
            const int i = i0 + u, c = dir == 0 ? c0 + i : c0 + n - 1 - i; const size_t slot = (size_t)(c * 4 + h) * 2 + dir;
            if constexpr (EL == 8) { u32x4 o; o.x = cvt_pk_bf16(S[0], S[1]); o.y = cvt_pk_bf16(S[2], S[3]); o.z = cvt_pk_bf16(S[4], S[5]); o.w = cvt_pk_bf16(S[6], S[7]); *(u32x4*)(ST + slot * 8192 + eo) = o; }
            else { u32x2 o; o.x = cvt_pk_bf16(S[0], S[1]); o.y = cvt_pk_bf16(S[2], S[3]); *(u32x2*)(ST + slot * 8192 + eo) = o; }
#pragma unroll
            for (int e = 0; e < EL / 2; ++e) { S[2 * e] = d[u][2 * e] * S[2 * e] + __uint_as_float(kv[u][e] << 16); S[2 * e + 1] = d[u][2 * e + 1] * S[2 * e + 1] + __uint_as_float(kv[u][e] & 0xffff0000u); }
        }
    }
}
__device__ __forceinline__ void gla_g2(const Params& p) {
    bf16_t* ST = (bf16_t*)(p.ws + WS_ST); const float* DEC = (const float*)(p.ws + WS_DEC);
    const int tid = ltid(), lane = tid & 63, wave = tid >> 6; const int gw = blockIdx.x * 8 + wave, NGW = gridDim.x * 8;
    if (gw < 256) { const int r = gw, h = r >> 6, dir = (r >> 5) & 1, part = r & 31; g2_scan<4, 16>(ST, DEC, 1024, 256, h, dir, part * 256 + lane * 4); }
    else if (NGW > 256) for (int it = gw - 256; it < 4096; it += NGW - 256) { const int c0 = (it >> 7) * 32, r = it & 127, h = r >> 5, dir = (r >> 4) & 1, part = r & 15; g2_scan<8, 8>(ST, DEC, c0, 32, h, dir, part * 512 + lane * 8); }
}

__device__ __forceinline__ void gla_g3_unit(const Params& p, LAS unsigned char* lds, int gc, int h, int un) {
    const bf16_t* Z = (const bf16_t*)(p.ws + WS_BIG); const bf16_t* ST = (const bf16_t*)(p.ws + WS_ST); bf16_t* OC = (bf16_t*)(p.ws + WS_ACTA);
    const int tid = ltid(), lane = tid & 63, wave = tid >> 6, dir = tid >> 8, qtr = (tid >> 6) & 3, kk = tid & 63, fr = lane & 15, quad = lane >> 4; const size_t tok0 = (size_t)gc * 64;
    u32x2 rr[4]; bf16x8 bf_[2], bb[2];
#pragma unroll
    for (int ti = 0; ti < 4; ++ti) rr[ti] = *(const u32x2*)(Z + (tok0 + ti * 16 + fr) * NZ + ZR + h * 128 + wave * 16 + quad * 4);
    { const bf16_t* Sf = ST + ((size_t)(gc * 4 + h) * 2 + 0) * 8192; const bf16_t* Sb = Sf + 8192;
#pragma unroll
      for (int ks = 0; ks < 2; ++ks) { const int o = ks * 32 + quad * 8; bf_[ks] = *(const bf16x8*)(Sf + (wave * 16 + fr) * 64 + o); bb[ks] = *(const bf16x8*)(Sb + (wave * 16 + fr) * 64 + o); } }
    gla_load(p, Z, lds, gc, h, true);
    const LAS bf16_t* kraw = (const LAS bf16_t*)(lds + GL_KR) + (qtr * 16) * 72 + kk; const LAS bf16_t* qraw = (const LAS bf16_t*)(lds + GL_QR) + (qtr * 16) * 72 + kk;
    float c[16], la[16], off, all; gla_gates(lds, c, la, off, all);
    LAS bf16_t* QK = (LAS bf16_t*)(lds + GL_A);
    { LAS bf16_t* Qd = QK + (dir * 2) * 64 * 72; LAS bf16_t* Kd = Qd + 64 * 72;
#pragma unroll
      for (int i = 0; i < 16; ++i) { const int t = qtr * 16 + i; const float b = dir == 0 ? off + c[i] : all - (off + c[i]) + la[i];
        const float b2 = LOG2E * b; Qd[t * 72 + kk] = f2bf1(bf2f(qraw[i * 72]) * __builtin_amdgcn_exp2f(b2)); Kd[t * 72 + kk] = f2bf1(bf2f(kraw[i * 72]) * __builtin_amdgcn_exp2f(-b2)); } }
    lds_barrier();
    const LAS bf16_t* Qf = QK; const LAS bf16_t* Kf = QK + 64 * 72; const LAS bf16_t* Qb = QK + 2 * 64 * 72; const LAS bf16_t* Kb = QK + 3 * 64 * 72;
    LAS bf16_t* P = (LAS bf16_t*)(lds + GL_P); const LAS bf16_t* vT = (const LAS bf16_t*)(lds + GL_VT);
#pragma unroll
    for (int pp = 0; pp < 2; ++pp) { const int pt = 2 * wave + pp, ti = pt >> 2, tj = pt & 3; f32x4 af = {0.f, 0.f, 0.f, 0.f}, ab = {0.f, 0.f, 0.f, 0.f};
#pragma unroll
        for (int ks = 0; ks < 2; ++ks) { const int o = ks * 32 + quad * 8;
            af = MFMA16(*(const LAS bf16x8*)(Kf + (tj * 16 + fr) * 72 + o), *(const LAS bf16x8*)(Qf + (ti * 16 + fr) * 72 + o), af);
            ab = MFMA16(*(const LAS bf16x8*)(Kb + (tj * 16 + fr) * 72 + o), *(const LAS bf16x8*)(Qb + (ti * 16 + fr) * 72 + o), ab); }
        float pv[4];
#pragma unroll
        for (int j = 0; j < 4; ++j) { const int s = tj * 16 + quad * 4 + j, t = ti * 16 + fr; pv[j] = (s <= t ? af[j] : 0.f) + (s >= t ? ab[j] : 0.f); }
        u32x2 o; o.x = cvt_pk_bf16(pv[0], pv[1]); o.y = cvt_pk_bf16(pv[2], pv[3]);
        *(LAS u32x2*)(P + (ti * 16 + fr) * 72 + tj * 16 + quad * 4) = o; }
    lds_barrier();
    f32x4 acc[4];
    { bf16x8 av[2];
#pragma unroll
      for (int ks = 0; ks < 2; ++ks) av[ks] = *(const LAS bf16x8*)(vT + (wave * 16 + fr) * 72 + ks * 32 + quad * 8);
#pragma unroll
      for (int ti = 0; ti < 4; ++ti) { f32x4 a = {0.f, 0.f, 0.f, 0.f};
#pragma unroll
          for (int ks = 0; ks < 2; ++ks) { const int o = ks * 32 + quad * 8;
              a = MFMA16(av[ks], *(const LAS bf16x8*)(P + (ti * 16 + fr) * 72 + o), a);
              a = MFMA16(bf_[ks], *(const LAS bf16x8*)(Qf + (ti * 16 + fr) * 72 + o), a);
              a = MFMA16(bb[ks], *(const LAS bf16x8*)(Qb + (ti * 16 + fr) * 72 + o), a); }
          acc[ti] = a; } }
    LAS float* ssw = (LAS float*)(lds + GL_SS);
#pragma unroll
    for (int ti = 0; ti < 4; ++ti) { float s = (acc[ti][0] * acc[ti][0] + acc[ti][1] * acc[ti][1]) + (acc[ti][2] * acc[ti][2] + acc[ti][3] * acc[ti][3]);
        s = quad_sum(s); if (quad == 0) ssw[wave * 64 + ti * 16 + fr] = s; }
    lds_barrier();
    { const int dv0 = h * 128 + wave * 16 + quad * 4; const f32x4 g = *(const f32x4*)(p.in[12] + dv0);
      u32x2 oo[4];
#pragma unroll
      for (int ti = 0; ti < 4; ++ti) { const int t = ti * 16 + fr; float tot = 0.f;
#pragma unroll
          for (int w8 = 0; w8 < 8; ++w8) tot += ssw[w8 * 64 + t];
          const float rinv = rsqrtf(tot * (1.0f / 128.0f) + EPS);
          const float r0 = __uint_as_float(rr[ti].x << 16), r1 = __uint_as_float(rr[ti].x & 0xffff0000u), r2 = __uint_as_float(rr[ti].y << 16), r3 = __uint_as_float(rr[ti].y & 0xffff0000u);
#define SILU_(r_) ((r_) * __builtin_amdgcn_rcpf(1.0f + __builtin_amdgcn_exp2f(-LOG2E * (r_))))
          oo[ti].x = cvt_pk_bf16(acc[ti][0] * rinv * g[0] * SILU_(r0), acc[ti][1] * rinv * g[1] * SILU_(r1));
          oo[ti].y = cvt_pk_bf16(acc[ti][2] * rinv * g[2] * SILU_(r2), acc[ti][3] * rinv * g[3] * SILU_(r3));
#undef SILU_
      }
#pragma unroll
      for (int tp = 0; tp < 2; ++tp) {
          const auto rx = __builtin_amdgcn_permlane16_swap(oo[2 * tp].x, oo[2 * tp + 1].x, false, false), ry = __builtin_amdgcn_permlane16_swap(oo[2 * tp].y, oo[2 * tp + 1].y, false, false);
          u32x4 w; w.x = rx[0]; w.y = ry[0]; w.z = rx[1]; w.w = ry[1];
          const int t = ((quad & 1) ? 2 * tp + 1 : 2 * tp) * 16 + fr, dvs = (quad & 1) ? dv0 - 4 : dv0;
          *(u32x4*)(OC + (tok0 + t) * DM + dvs) = w; } }
    lds_barrier();
}
constexpr int AT_TILE = 512, AT_O = 0  , AT_M = AT_TILE * 68 * 4, AT_L = AT_M + AT_TILE * 4;
__device__ __forceinline__ void attn_group(int br, int g, int p0, int& cls, int& qi) {
    if (br == 0) { cls = 0; qi = p0 + 32 * g; } else if (br == 1) { cls = g >> 2; qi = (p0 >> 2) + 32 * (g & 3); } else { cls = g; qi = p0 >> 4; }
}
__device__ __forceinline__ void attn_load(const bf16_t* Zh, int s0, int sh, int n, int cls, int kb, int lane, bf16x8 (&k)[4], bf16x8 (&v)[4]) {
    const int fr = lane & 15, quad = lane >> 4;
    if (kb >= 0 && kb + 32 <= n) {
        const unsigned o0 = (unsigned)(s0 + ((kb + fr) << sh) + cls) * (unsigned)NZ + quad * 8, o1 = o0 + ((unsigned)(16 << sh)) * (unsigned)NZ;
        k[0] = *(const bf16x8*)(Zh + o0 + ZAK); k[1] = *(const bf16x8*)(Zh + o0 + ZAK + 32); v[0] = *(const bf16x8*)(Zh + o0 + ZAV); v[1] = *(const bf16x8*)(Zh + o0 + ZAV + 32);
        k[2] = *(const bf16x8*)(Zh + o1 + ZAK); k[3] = *(const bf16x8*)(Zh + o1 + ZAK + 32); v[2] = *(const bf16x8*)(Zh + o1 + ZAV); v[3] = *(const bf16x8*)(Zh + o1 + ZAV + 32);
    } else {
#pragma unroll
        for (int kt = 0; kt < 2; ++kt) { int ki = kb + kt * 16 + fr; ki = ki < 0 ? 0 : (ki >= n ? n - 1 : ki);
            const bf16_t* r = Zh + (unsigned)(s0 + (ki << sh) + cls) * (unsigned)NZ + quad * 8;
            k[kt * 2] = *(const bf16x8*)(r + ZAK); k[kt * 2 + 1] = *(const bf16x8*)(r + ZAK + 32); v[kt * 2] = *(const bf16x8*)(r + ZAV); v[kt * 2 + 1] = *(const bf16x8*)(r + ZAV + 32); }
    }
}
__device__ __forceinline__ void attn_unit(const Params& p, LAS unsigned char* lds, int tile, int h, int variant) {
    const bf16_t* Zh = (const bf16_t*)(p.ws + WS_BIG) + h * 64; bf16_t* OC = (bf16_t*)(p.ws + WS_ACTA);
    const int tid = ltid(), lane = tid & 63, wave = tid >> 6, fr = lane & 15, quad = lane >> 4;
    const int T0 = tile * AT_TILE, s0 = T0 < MPROMPT ? (T0 & ~2047) : MPROMPT, L = T0 < MPROMPT ? 2048 : 16384, p0 = T0 - s0;
    LAS float* Ol = (LAS float*)(lds + AT_O); LAS float* ml = (LAS float*)(lds + AT_M); LAS float* ll = (LAS float*)(lds + AT_L);
    const float slope2 = exp2f(-(float)(h + 1)) * LOG2E;
    bf16x8 isel[2];
#pragma unroll
    for (int hf = 0; hf < 2; ++hf)
#pragma unroll
        for (int jj = 0; jj < 8; ++jj) isel[hf][jj] = (quad * 8 + jj == hf * 16 + fr) ? (short)0x3F80 : (short)0;
#pragma unroll 1
    for (int br = 0; br < 3; ++br) {
        const int sh = 2 * br, n = L >> sh; const float nbc = -slope2 * (float)(1 << sh);
        bf16x8 kf[4], vf[4];
        { int cls, qi; attn_group(br, 2 * wave, p0, cls, qi); attn_load(Zh, s0, sh, n, cls, qi - 64, lane, kf, vf); }
        bf16x8 qf[2][2]; float m[2], l[2]; f32x4 O[2][4]; int tq[2], tl[2];
#pragma unroll
        for (int nt = 0; nt < 2; ++nt) { m[nt] = -1e30f; l[nt] = 0.f; tq[nt] = 0; tl[nt] = 0; qf[nt][0] = kf[0]; qf[nt][1] = kf[0];
#pragma unroll
            for (int dt = 0; dt < 4; ++dt) O[nt][dt] = (f32x4){0.f, 0.f, 0.f, 0.f}; }
#pragma unroll 1
        for (int it = 0; it < 10; ++it) {
            const int gg = it >= 5 ? 1 : 0, ch = it - 5 * gg;
            int cls, qi; attn_group(br, 2 * wave + gg, p0, cls, qi);
            if (ch == 0) {
#pragma unroll
                for (int nt = 0; nt < 2; ++nt) {
                    tq[nt] = s0 + ((qi + 16 * nt + fr) << sh) + cls; tl[nt] = tq[nt] - T0;
#pragma unroll
                    for (int ks = 0; ks < 2; ++ks) qf[nt][ks] = *(const bf16x8*)(Zh + (unsigned)tq[nt] * (unsigned)NZ + ZAQ + ks * 32 + quad * 8);
                    if (br == 0) { m[nt] = -1e30f; l[nt] = 0.f;
#pragma unroll
                        for (int dt = 0; dt < 4; ++dt) O[nt][dt] = (f32x4){0.f, 0.f, 0.f, 0.f};
                    } else { m[nt] = ml[tl[nt]]; l[nt] = quad == 0 ? ll[tl[nt]] : 0.f;
#pragma unroll
                        for (int dt = 0; dt < 4; ++dt) O[nt][dt] = *(const LAS f32x4*)(Ol + tl[nt] * 68 + dt * 16 + quad * 4); }
                }
            }
            const int kb = qi - 64 + 32 * ch;
            f32x4 S[2][2], vt[2][4];
#pragma unroll
            for (int nt = 0; nt < 2; ++nt)
#pragma unroll
                for (int kt = 0; kt < 2; ++kt) { f32x4 a = {0.f, 0.f, 0.f, 0.f}; a = MFMA16(kf[kt * 2], qf[nt][0], a); a = MFMA16(kf[kt * 2 + 1], qf[nt][1], a); S[nt][kt] = a; }
#pragma unroll
            for (int kt = 0; kt < 2; ++kt)
#pragma unroll
                for (int dt = 0; dt < 4; ++dt) vt[kt][dt] = MFMA16(vf[kt * 2 + (dt >> 1)], isel[dt & 1], ((f32x4){0.f, 0.f, 0.f, 0.f}));
            if (it < 9 && variant != 1) { const int g2 = it + 1 >= 5 ? 1 : 0, ch2 = it + 1 - 5 * g2; int cls2, qi2; attn_group(br, 2 * wave + g2, p0, cls2, qi2);
                attn_load(Zh, s0, sh, n, cls2, qi2 - 64 + 32 * ch2, lane, kf, vf); }
            bf16x8 vtp[4];
#pragma unroll
            for (int dt = 0; dt < 4; ++dt) { u32x4 vw; vw.x = cvt_pk_bf16(vt[0][dt][0], vt[0][dt][1]); vw.y = cvt_pk_bf16(vt[0][dt][2], vt[0][dt][3]); vw.z = cvt_pk_bf16(vt[1][dt][0], vt[1][dt][1]); vw.w = cvt_pk_bf16(vt[1][dt][2], vt[1][dt][3]);
                vtp[dt] = __builtin_bit_cast(bf16x8, vw); }
            const bool seqedge = (kb < 0 || kb + 32 > n);
#pragma unroll
            for (int nt = 0; nt < 2; ++nt) {
                float sv[8]; float mx = -1e30f;
                const int relb = -64 + 32 * ch + quad * 4 - fr - 16 * nt;
                if (seqedge) {
#pragma unroll
                    for (int kt = 0; kt < 2; ++kt)
#pragma unroll
                        for (int j = 0; j < 4; ++j) { const int rel = relb + kt * 16 + j, key = qi + 16 * nt + fr + rel, ar = rel < 0 ? -rel : rel;
                            const bool ok = (ar <= 64) && ((unsigned)key < (unsigned)n); const float s = ok ? fmaf(nbc, (float)ar, S[nt][kt][j]) : -3.0e38f; sv[kt * 4 + j] = s; mx = fmaxf(mx, s); }
                } else { const float frel = (float)relb; const int dl = fr + 16 * nt - quad * 4;
                    if (ch == 0) {
#pragma unroll
                        for (int kt = 0; kt < 2; ++kt)
#pragma unroll
                            for (int j = 0; j < 4; ++j) { float s = fmaf(nbc, fabsf(frel + (float)(kt * 16 + j)), S[nt][kt][j]); s = (kt * 16 + j >= dl) ? s : -3.0e38f; sv[kt * 4 + j] = s; mx = fmaxf(mx, s); }
                    } else if (ch == 4) {
#pragma unroll
                        for (int kt = 0; kt < 2; ++kt)
#pragma unroll
                            for (int j = 0; j < 4; ++j) { float s = fmaf(nbc, fabsf(frel + (float)(kt * 16 + j)), S[nt][kt][j]); s = (kt * 16 + j <= dl) ? s : -3.0e38f; sv[kt * 4 + j] = s; mx = fmaxf(mx, s); }
                    } else {
#pragma unroll
                        for (int kt = 0; kt < 2; ++kt)
#pragma unroll
                            for (int j = 0; j < 4; ++j) { const float s = fmaf(nbc, fabsf(frel + (float)(kt * 16 + j)), S[nt][kt][j]); sv[kt * 4 + j] = s; mx = fmaxf(mx, s); }
                    }
                }
                if (!__all(mx - m[nt] <= 8.0f)) {
                    mx = quad_max(mx);
                    const float mn = fmaxf(m[nt], mx), alpha = __builtin_amdgcn_exp2f(m[nt] - mn);
                    l[nt] *= alpha; m[nt] = mn;
#pragma unroll
                    for (int dt = 0; dt < 4; ++dt) O[nt][dt] = O[nt][dt] * alpha;
                }
                float ps = 0.f; float pv[8]; const float mcur = m[nt];
#pragma unroll
                for (int e = 0; e < 8; ++e) { pv[e] = __builtin_amdgcn_exp2f(sv[e] - mcur); ps += pv[e]; }
                l[nt] += ps;
                u32x4 pw; pw.x = cvt_pk_bf16(pv[0], pv[1]); pw.y = cvt_pk_bf16(pv[2], pv[3]); pw.z = cvt_pk_bf16(pv[4], pv[5]); pw.w = cvt_pk_bf16(pv[6], pv[7]);
                const bf16x8 pf = __builtin_bit_cast(bf16x8, pw);
#pragma unroll
                for (int dt = 0; dt < 4; ++dt) O[nt][dt] = MFMA16(vtp[dt], pf, O[nt][dt]);
            }
            if (ch == 4) {
#pragma unroll
                for (int nt = 0; nt < 2; ++nt) {
                    const float lt = quad_sum(l[nt]);
                    if (br < 2) { if (quad == 0) { ml[tl[nt]] = m[nt]; ll[tl[nt]] = lt; }
#pragma unroll
                        for (int dt = 0; dt < 4; ++dt) *(LAS f32x4*)(Ol + tl[nt] * 68 + dt * 16 + quad * 4) = O[nt][dt];
                    } else { const float inv = 1.0f / lt; u32x2 oo[4];
#pragma unroll
                        for (int dt = 0; dt < 4; ++dt) { oo[dt].x = cvt_pk_bf16(O[nt][dt][0] * inv, O[nt][dt][1] * inv); oo[dt].y = cvt_pk_bf16(O[nt][dt][2] * inv, O[nt][dt][3] * inv); }
#pragma unroll
                        for (int dp = 0; dp < 2; ++dp) {
                            const auto rx = __builtin_amdgcn_permlane16_swap(oo[2 * dp].x, oo[2 * dp + 1].x, false, false), ry = __builtin_amdgcn_permlane16_swap(oo[2 * dp].y, oo[2 * dp + 1].y, false, false);
                            u32x4 w; w.x = rx[0]; w.y = ry[0]; w.z = rx[1]; w.w = ry[1];
                            const int col = (quad & 1) ? (2 * dp + 1) * 16 + (quad - 1) * 4 : (2 * dp) * 16 + quad * 4;
                            *(u32x4*)(OC + (size_t)tq[nt] * DM + 512 + h * 64 + col) = w; } }
                }
            }
        }
        lds_barrier();
    }
}
__global__ void __launch_bounds__(NTHREADS, 2) hymba_fwd(Params p) {
    extern __shared__ __attribute__((aligned(16))) unsigned char smem[];
    LAS unsigned char* lds = (LAS unsigned char*)smem;
    cg::grid_group grid = cg::this_grid();
    volatile LAS unsigned* bst = (volatile LAS unsigned*)(lds + LDS_BYTES - 64);
    if (threadIdx.x < 2) bst[threadIdx.x] = 0u;
    __syncthreads();
    const XcdBarrier xbar = xcd_barrier_post((unsigned*)(p.ws + WS_BAR), bst);
    unsigned char* ws = p.ws;
    float* ssq = (float*)(ws + WS_SSQ);
    bf16_t* actA = (bf16_t*)(ws + WS_ACTA); bf16_t* big = (bf16_t*)(ws + WS_BIG);
    bf16_t* hb0 = (bf16_t*)p.out; bf16_t* hb1 = hb0 + (size_t)MTOK * DM;
    pg8::StaticOrder S;
    for (int rep = 0; rep < PROBE_PRO; ++rep) prologue(p, lds);
    grid.sync();
    { pg8::Gemm g{actA, (const bf16_t*)(ws + WS_W1GU), MTOK, NGU, DM}; S.init(MTOK, NGU, gridDim.x, blockIdx.x); EpiSwiglu E{big, ssq};
      pg8::gemm_phase<EpiSwiglu, pg8::StaticOrder, true, true>(lds, g, S, E);
      if (PROBE_P1 == 2) { xcd_barrier(xbar); pg8::gemm_phase<EpiSwiglu, pg8::StaticOrder, true, true>(lds, g, S, E); }
      { const int nwg = (MTOK / 256) * (NGU / 256), G = (int)gridDim.x, rem = nwg % G, c = (int)blockIdx.x; const int tid = ltid();
        if (c >= rem) deferred_weights(p, lds, (c - rem) * 8 + (tid >> 6), (G - rem) * 8); } }
    xcd_barrier(xbar);
    { pg8::Gemm g{big, (const bf16_t*)(ws + WS_W1D), MTOK, DM, DFF}; S.init(MTOK, DM, gridDim.x, blockIdx.x); EpiResid<true> E{nullptr, nullptr, 0, actA, hb0, ssq + MTOK, 0.5f};
      pg8::gemm_phase<EpiResid<true>, pg8::StaticOrder, true, true>(lds, g, S, E); }
    xcd_barrier(xbar);
    { pg8::Gemm g{hb0, (const bf16_t*)(ws + WS_WIN), MTOK, 3072, DM}; S.init(MTOK, 3072, gridDim.x, blockIdx.x); EpiZ E{big, ssq + MTOK};
      pg8::gemm_phase<EpiZ, pg8::StaticOrder, true, true>(lds, g, S, E); }
    for (int it = blockIdx.x; it < MTOK / 64; it += gridDim.x) lr_gemm_item(hb0, (const bf16_t*)(ws + WS_WIN) + (size_t)3072 * DM, ssq + MTOK, big, lds, it);
    xcd_barrier(xbar);
    for (int u = blockIdx.x; u < 160 * 8 * PROBE_ATT; u += gridDim.x) attn_unit(p, lds, (u % 1280) >> 3, u & 7, (PROBE_ATT == 2 && u < 1280) ? PROBE_VAR : 0);
    for (int u = blockIdx.x; u < NCHUNK * 4 * PROBE_G1; u += gridDim.x) gla_g1_unit(p, lds, (u % (NCHUNK * 4)) >> 2, u & 3, u + gridDim.x);
    xcd_barrier(xbar);
    gla_g2(p);
    xcd_barrier(xbar);
    for (int u = blockIdx.x; u < NCHUNK * 4 * PROBE_G3; u += gridDim.x) gla_g3_unit(p, lds, (u % (NCHUNK * 4)) >> 2, u & 3, u + gridDim.x);
    xcd_barrier(xbar);
    { pg8::Gemm g{actA, (const bf16_t*)(ws + WS_WOUT), MTOK, DM, DM}; S.init(MTOK, DM, gridDim.x, blockIdx.x); EpiResid<true> E{nullptr, nullptr, 0, hb0, hb1, ssq + 2 * MTOK, 1.0f};
      pg8::gemm_phase<EpiResid<true>, pg8::StaticOrder, true, true>(lds, g, S, E); }
    xcd_barrier(xbar);
    { pg8::Gemm g{hb1, (const bf16_t*)(ws + WS_W2GU), MTOK, NGU, DM}; S.init(MTOK, NGU, gridDim.x, blockIdx.x); EpiSwiglu E{big, ssq + 2 * MTOK};
      pg8::gemm_phase<EpiSwiglu, pg8::StaticOrder, true, true>(lds, g, S, E); }
    xcd_barrier(xbar);
    { pg8::Gemm g{big, (const bf16_t*)(ws + WS_W2D), MTOK, DM, DFF}; S.init(MTOK, DM, gridDim.x, blockIdx.x); EpiResid<true> E{nullptr, nullptr, 0, hb1, actA, ssq + 3 * MTOK, 0.5f};
      pg8::gemm_phase<EpiResid<true>, pg8::StaticOrder, true, true>(lds, g, S, E); }
    xcd_barrier(xbar);
    { const int tid = ltid(), lane = tid & 63, wave = tid >> 6; const int gw = blockIdx.x * 8 + wave, NGW = gridDim.x * 8; const float* gf = p.in[18];
      f32x4 gv[4];
#pragma unroll
      for (int j = 0; j < 4; ++j) gv[j] = ((const f32x4*)gf)[2 * lane + (j & 1) + 128 * (j >> 1)];
      for (int row = gw; row < MTOK; row += 2 * NGW) {
          const int row2 = row + NGW < MTOK ? row + NGW : row;
          const u32x4 a0 = ((const u32x4*)(actA + (size_t)row * DM))[lane], a1 = ((const u32x4*)(actA + (size_t)row * DM))[lane + 64];
          const u32x4 b0 = ((const u32x4*)(actA + (size_t)row2 * DM))[lane], b1 = ((const u32x4*)(actA + (size_t)row2 * DM))[lane + 64];
          const float rs = rsqrtf(ssq[3 * MTOK + row] * (1.0f / DM) + EPS), rs2 = rsqrtf(ssq[3 * MTOK + row2] * (1.0f / DM) + EPS);
#define P10_OUT(rw, scale, q0, q1) do { f32x4* o = (f32x4*)(p.out + (size_t)(rw) * DM); \
          o[2 * lane] = (f32x4){__uint_as_float(q0.x << 16), __uint_as_float(q0.x & 0xffff0000u), __uint_as_float(q0.y << 16), __uint_as_float(q0.y & 0xffff0000u)} * (scale) * gv[0]; \
          o[2 * lane + 1] = (f32x4){__uint_as_float(q0.z << 16), __uint_as_float(q0.z & 0xffff0000u), __uint_as_float(q0.w << 16), __uint_as_float(q0.w & 0xffff0000u)} * (scale) * gv[1]; \
          o[128 + 2 * lane] = (f32x4){__uint_as_float(q1.x << 16), __uint_as_float(q1.x & 0xffff0000u), __uint_as_float(q1.y << 16), __uint_as_float(q1.y & 0xffff0000u)} * (scale) * gv[2]; \
          o[128 + 2 * lane + 1] = (f32x4){__uint_as_float(q1.z << 16), __uint_as_float(q1.z & 0xffff0000u), __uint_as_float(q1.w << 16), __uint_as_float(q1.w & 0xffff0000u)} * (scale) * gv[3]; } while (0)
          P10_OUT(row, rs, a0, a1);
          if (row2 != row) P10_OUT(row2, rs2, b0, b1);
#undef P10_OUT
      } }
}

extern "C" void kernel_launch(void* const* d_in, const int* in_sizes, int n_in, void* d_out, int out_size, void* d_ws, size_t ws_size, hipStream_t stream) {
    static int grid = 0;
    if (grid == 0) {
        if (n_in != 19 || out_size != MTOK * DM || ws_size < WS_END) { fprintf(stderr, "kernel_launch: unexpected shapes (n_in %d out %d ws %zu)\n", n_in, out_size, ws_size); grid = -1; return; }
        int dev = 0, cus = 0, per_cu = 0;
        hipGetDevice(&dev); hipDeviceGetAttribute(&cus, hipDeviceAttributeMultiprocessorCount, dev);
        if (hipFuncSetAttribute((const void*)hymba_fwd, hipFuncAttributeMaxDynamicSharedMemorySize, LDS_BYTES) != hipSuccess) { fprintf(stderr, "kernel_launch: hipFuncSetAttribute failed\n"); grid = -1; return; }
        if (hipOccupancyMaxActiveBlocksPerMultiprocessor(&per_cu, (const void*)hymba_fwd, NTHREADS, LDS_BYTES) != hipSuccess || per_cu < 1) { fprintf(stderr, "kernel_launch: occupancy query gave %d\n", per_cu); per_cu = 1; }
        (void)hipGetLastError();
        grid = cus * 1;
    }
    if (grid < 0) return;
    if (hipMemsetAsync((char*)d_ws + WS_BAR, 0, XCD_BAR_WORDS * 4, stream) != hipSuccess) { fprintf(stderr, "kernel_launch: memset of the barrier words failed\n"); return; }
    Params p{};
    for (int i = 0; i < 19; ++i) p.in[i] = (const float*)d_in[i];
    p.out = (float*)d_out; p.ws = (unsigned char*)d_ws;
    void* args[] = {&p};
    hipError_t e = hipLaunchCooperativeKernel((const void*)hymba_fwd, dim3(grid), dim3(NTHREADS), args, LDS_BYTES, stream);
    if (e != hipSuccess) fprintf(stderr, "cooperative launch failed: %s (grid %d)\n", hipGetErrorString(e), grid);
}
```
